# Optimizing an MI355X kernel written in HIP

```python
import math
import jax
import jax.numpy as jnp
from jax import lax
import numpy as np

D_MODEL = 1024
BATCH = 32
SEQ = 256
DEPTH = 2
DEC_BATCH = 4
DEC_SEQ = 2048
PAST_LEN = 512

GRID_W = 64
MIX_DIM = D_MODEL
V_DIM = 128
QK_DIM = V_DIM // 2
N_ATT_HEADS = (MIX_DIM // 2) // V_DIM
CONV_DIM = MIX_DIM // 4
N_CONV_GROUPS = 4
FOURIER_DIM = MIX_DIM // 4
N_FOURIER_GROUPS = 4
FOURIER_GROUP_DIM = FOURIER_DIM // N_FOURIER_GROUPS
ATT_QK = N_ATT_HEADS * 2 * QK_DIM
ATT_V = N_ATT_HEADS * V_DIM
IN_DIM = 2 * ATT_QK + ATT_V + 3 * CONV_DIM + FOURIER_DIM
SPLITS = (ATT_QK, 2 * ATT_QK, 2 * ATT_QK + ATT_V,
          2 * ATT_QK + ATT_V + CONV_DIM,
          2 * ATT_QK + ATT_V + 2 * CONV_DIM,
          2 * ATT_QK + ATT_V + 3 * CONV_DIM)
D_FF = ((8 * D_MODEL // 3 + 127) // 128) * 128
CONV_WIDTH = 3
N_MOD = 9
ROT_AXIS_DIM = QK_DIM // 2
ROT_FREQS = ROT_AXIS_DIM // 2
ROPE_THETA = 10000.0
Q_BLOCK = 128
FFN_RESIDUAL_WEIGHT = 0.5
EPS = 1e-6

kernel_name = "hybrid_diffattn_conv_fourier_dit_step"


def _lambda_init(layer_idx):
    return 0.8 - 0.6 * math.exp(-0.3 * layer_idx)


def _rmsnorm(x, g):
    xf = x.astype(jnp.float32)
    y = xf * lax.rsqrt(jnp.mean(xf * xf, axis=-1, keepdims=True) + EPS)
    return (y * g.astype(jnp.float32)).astype(x.dtype)


def _modulation(cvec, w_mod_l, b_mod_l):
    m = jax.nn.silu(cvec) @ w_mod_l + b_mod_l
    return m.reshape(-1, 1, N_MOD, D_MODEL)


def _axial_angles(n):
    rows = n // GRID_W
    t = jnp.arange(rows * GRID_W)
    row = (t // GRID_W).astype(jnp.float32)
    col = (t % GRID_W).astype(jnp.float32)
    inv = 1.0 / (ROPE_THETA ** (jnp.arange(ROT_FREQS, dtype=jnp.float32) / ROT_FREQS))
    return row[:, None] * inv, col[:, None] * inv


def _rot(x, ang):
    cos = jnp.cos(ang)[None, :, None, None, :].astype(x.dtype)
    sin = jnp.sin(ang)[None, :, None, None, :].astype(x.dtype)
    x1, x2 = x[..., :ROT_FREQS], x[..., ROT_FREQS:]
    return jnp.concatenate([x1 * cos - x2 * sin, x2 * cos + x1 * sin], axis=-1)


def _rope_2d(x, ang_r, ang_c):
    return jnp.concatenate([_rot(x[..., :ROT_AXIS_DIM], ang_r),
                            _rot(x[..., ROT_AXIS_DIM:], ang_c)], axis=-1)


def _diff_attention(q, k, v, lam, lambda_init, subln_g):
    b, lq, h, _, dk = q.shape
    nb = lq // Q_BLOCK
    qb = q.reshape(b, nb, Q_BLOCK, h, 2, dk).transpose(1, 0, 2, 3, 4, 5)
    scale = dk ** -0.5

    def one_block(qblk):
        s = jnp.einsum('bqhmd,bkhmd->bhmqk', qblk, k).astype(jnp.float32) * scale
        p = jax.nn.softmax(s, axis=-1)
        a = p[:, :, 0] - lam * p[:, :, 1]
        o = jnp.einsum('bhqk,bkhe->bqhe', a.astype(v.dtype), v)
        return _rmsnorm(o, subln_g) * (1.0 - lambda_init)

    ob = lax.map(one_block, qb)
    return ob.transpose(1, 0, 2, 3, 4).reshape(b, lq, h * v.shape[-1])


def _short_conv(u, w):
    up = jnp.pad(u, ((0, 0), (1, 1), (0, 0)))
    return up[:, :-2] * w[0] + up[:, 1:-1] * w[1] + up[:, 2:] * w[2]


def _fourier_mix(f):
    b, n, _ = f.shape
    ff = f.astype(jnp.float32).reshape(b, n, N_FOURIER_GROUPS, FOURIER_GROUP_DIM)
    out = jnp.fft.fft2(ff, axes=(1, 3), norm="ortho").real
    return out.reshape(b, n, FOURIER_DIM).astype(f.dtype)


def _ffn_sub(x, shift, scale, gate, g_pre, g_post, w_gu, w_down):
    h = _rmsnorm(x, g_pre) * (1 + scale) + shift
    g, u = jnp.split(h @ w_gu, 2, axis=-1)
    y = (jax.nn.silu(g) * u) @ w_down
    return x + FFN_RESIDUAL_WEIGHT * gate * _rmsnorm(y, g_post)


def _mixer_sub(x, shift, scale, gate, g_pre, g_post, w_in_l, conv_w_l, w_out_l,
               lam, lambda_init, subln_g_l, ctx_k, ctx_v):
    b, n, _ = x.shape
    h = _rmsnorm(x, g_pre) * (1 + scale) + shift
    p = h @ w_in_l
    q, k, v, gb, gc, hc, f = jnp.split(p, SPLITS, axis=-1)
    q = q.reshape(b, n, N_ATT_HEADS, 2, QK_DIM)
    k = k.reshape(b, n, N_ATT_HEADS, 2, QK_DIM)
    v = v.reshape(b, n, N_ATT_HEADS, V_DIM)
    if ctx_k is None:
        keys, vals = k, v
    else:
        ang_r, ang_c = _axial_angles(n)
        q = _rope_2d(q, ang_r, ang_c)
        keys = jnp.concatenate([_rope_2d(k, ang_r, ang_c), ctx_k.astype(k.dtype)], axis=1)
        vals = jnp.concatenate([v, ctx_v.astype(v.dtype)], axis=1)
    att = _diff_attention(q, keys, vals, lam, lambda_init, subln_g_l)
    conv = gb * _short_conv(gc * hc, conv_w_l)
    four = _fourier_mix(f)
    y = jnp.concatenate([att, conv, four], axis=-1) @ w_out_l
    return x + gate * _rmsnorm(y, g_post), k, v


def _layer(x, l, cvec, w_mod, b_mod, norm_g, w_ffn_gu, w_ffn_down, w_in, w_out,
           conv_w, lam_qk, subln_g, ctx_k, ctx_v):
    mod = _modulation(cvec, w_mod[l], b_mod[l])
    g = norm_g[l]
    lambda_init = _lambda_init(l)
    lq = lam_qk[l].astype(jnp.float32)
    lam = jnp.exp(jnp.sum(lq[0] * lq[1])) - jnp.exp(jnp.sum(lq[2] * lq[3])) + lambda_init
    x = _ffn_sub(x, mod[:, :, 0], mod[:, :, 1], mod[:, :, 2], g[0], g[1],
                 w_ffn_gu[l, 0], w_ffn_down[l, 0])
    x, k, v = _mixer_sub(x, mod[:, :, 3], mod[:, :, 4], mod[:, :, 5], g[2], g[3],
                         w_in[l], conv_w[l], w_out[l], lam, lambda_init, subln_g[l],
                         ctx_k, ctx_v)
    x = _ffn_sub(x, mod[:, :, 6], mod[:, :, 7], mod[:, :, 8], g[4], g[5],
                 w_ffn_gu[l, 1], w_ffn_down[l, 1])
    return x, k, v


def setup_inputs(seed: int = 0) -> dict:
    key = jax.random.key(seed)
    ks = jax.random.split(key, 16)
    f32 = jnp.float32
    x_prompt = jax.random.normal(ks[0], (BATCH, SEQ, D_MODEL), f32)
    x_sample = jax.random.normal(ks[1], (DEC_BATCH, DEC_SEQ, D_MODEL), f32)
    cache_k = jax.random.normal(ks[2], (DEC_BATCH, DEPTH, PAST_LEN, N_ATT_HEADS, 2, QK_DIM), f32)
    cache_v = jax.random.normal(ks[3], (DEC_BATCH, DEPTH, PAST_LEN, N_ATT_HEADS, V_DIM), f32)
    c = jax.random.normal(ks[4], (DEC_BATCH, D_MODEL), f32)
    c_ctx = jax.random.normal(ks[5], (D_MODEL,), f32)
    w_mod = jax.random.normal(ks[6], (DEPTH, D_MODEL, N_MOD * D_MODEL), f32) * (0.5 * D_MODEL ** -0.5)
    b_mod = jax.random.normal(ks[7], (DEPTH, N_MOD * D_MODEL), f32) * 0.02
    norm_g = 1.0 + 0.02 * jax.random.normal(ks[8], (DEPTH, 6, D_MODEL), f32)
    w_ffn_gu = jax.random.normal(ks[9], (DEPTH, 2, D_MODEL, 2 * D_FF), f32) * D_MODEL ** -0.5
    w_ffn_down = jax.random.normal(ks[10], (DEPTH, 2, D_FF, D_MODEL), f32) * D_FF ** -0.5
    w_in = jax.random.normal(ks[11], (DEPTH, D_MODEL, IN_DIM), f32) * D_MODEL ** -0.5
    w_out = jax.random.normal(ks[12], (DEPTH, MIX_DIM, D_MODEL), f32) * MIX_DIM ** -0.5
    conv_w = jax.random.normal(ks[13], (DEPTH, CONV_WIDTH, CONV_DIM), f32) * CONV_WIDTH ** -0.5
    lam_qk = jax.random.normal(ks[14], (DEPTH, 4, QK_DIM), f32) * 0.1
    subln_g = 1.0 + 0.02 * jax.random.normal(ks[15], (DEPTH, V_DIM), f32)
    return {"x_prompt": x_prompt, "x_sample": x_sample, "cache_k": cache_k, "cache_v": cache_v,
            "c": c, "c_ctx": c_ctx, "w_mod": w_mod, "b_mod": b_mod, "norm_g": norm_g,
            "w_ffn_gu": w_ffn_gu, "w_ffn_down": w_ffn_down, "w_in": w_in, "w_out": w_out,
            "conv_w": conv_w, "lam_qk": lam_qk, "subln_g": subln_g}


def reference(x_prompt, x_sample, cache_k, cache_v, c, c_ctx, w_mod, b_mod, norm_g,
              w_ffn_gu, w_ffn_down, w_in, w_out, conv_w, lam_qk, subln_g):
    y_prompt = x_prompt
    ks, vs = [], []
    for l in range(DEPTH):
        y_prompt, k, v = _layer(y_prompt, l, c_ctx, w_mod, b_mod, norm_g, w_ffn_gu, w_ffn_down,
                                w_in, w_out, conv_w, lam_qk, subln_g, None, None)
        ks.append(k)
        vs.append(v)
    new_cache_k = jnp.stack(ks, axis=1)
    new_cache_v = jnp.stack(vs, axis=1)
    y_sample = x_sample
    for l in range(DEPTH):
        y_sample, _, _ = _layer(y_sample, l, c, w_mod, b_mod, norm_g, w_ffn_gu, w_ffn_down,
                                w_in, w_out, conv_w, lam_qk, subln_g,
                                cache_k[:, l], cache_v[:, l])
    return (y_prompt, y_sample, new_cache_k, new_cache_v)
```

```cpp
#include <hip/hip_runtime.h>
#include <hip/hip_cooperative_groups.h>
#include <cstdio>
namespace cg = cooperative_groups;

#ifndef MK_PER_PHASE
#define MK_PER_PHASE 0
#endif

#ifndef PROBE_MASK
#define PROBE_MASK 0
#endif
#define LAS __attribute__((address_space(3)))
typedef unsigned short bf16_t;
typedef short bf16x8 __attribute__((ext_vector_type(8)));
typedef short bf16x4 __attribute__((ext_vector_type(4)));
typedef float f32x4 __attribute__((ext_vector_type(4)));
typedef unsigned u32x2 __attribute__((ext_vector_type(2)));
typedef unsigned u32x4 __attribute__((ext_vector_type(4)));

constexpr int DM = 1024, NTOK = 16384, NCTX = 8192, DFF = 2816, NIN = 2816;
constexpr int LDS_BYTES = 131072 + 1024;
constexpr int NPHASE = 22;

constexpr size_t SZ_WGU = (size_t)5632 * 1024 * 2, SZ_WDN = (size_t)1024 * 2816 * 2, SZ_WIN = (size_t)2816 * 1024 * 2, SZ_WOUT = (size_t)1024 * 1280 * 2;
constexpr size_t OFF_WGU = 0;
constexpr size_t OFF_WDN = OFF_WGU + 4 * SZ_WGU;
constexpr size_t OFF_WIN = OFF_WDN + 4 * SZ_WDN;
constexpr size_t OFF_WOUT = OFF_WIN + 2 * SZ_WIN;
constexpr size_t OFF_DLAT = OFF_WOUT + 2 * SZ_WOUT;
constexpr size_t OFF_DCTX = OFF_DLAT + (size_t)2048 * 4096 * 2;
constexpr size_t OFF_MOD = OFF_DCTX + (size_t)256 * 512 * 2;
constexpr size_t OFF_ROPE = OFF_MOD + (size_t)2 * 5 * 9216 * 4;
constexpr size_t OFF_MISC = OFF_ROPE + 8192;
constexpr size_t OFF_CTL = OFF_MISC + 1024;
constexpr size_t CTL_BYTES = 32768;
constexpr size_t OFF_H = OFF_CTL + CTL_BYTES;
constexpr size_t OFF_Y = OFF_H;
constexpr size_t OFF_XB = OFF_H + (size_t)NTOK * 1024 * 2;
constexpr size_t OFF_U = OFF_XB + (size_t)NTOK * 1024 * 2;
constexpr size_t OFF_ACT = OFF_U;
constexpr size_t OFF_Q = OFF_U;
constexpr size_t OFF_KC = OFF_Q + (size_t)NTOK * 512 * 2;
constexpr size_t OFF_VTC = OFF_KC + (size_t)32 * 4 * 256 * 128 * 2;
constexpr size_t OFF_KL = OFF_VTC + (size_t)32 * 4 * 128 * 256 * 2;
constexpr size_t OFF_VTL = OFF_KL + (size_t)4 * 4 * 2560 * 128 * 2;
constexpr size_t OFF_CONV = OFF_VTL + (size_t)4 * 4 * 128 * 2560 * 2;
constexpr size_t OFF_FTL = OFF_CONV + (size_t)3 * NTOK * 256 * 2;
constexpr size_t OFF_FTC = OFF_FTL + (size_t)1024 * 4096 * 2;
constexpr size_t END_MIX = OFF_FTC + (size_t)8192 * 512 * 2;
constexpr size_t END_ACT = OFF_ACT + (size_t)NTOK * DFF * 2;
constexpr size_t OFF_CAT = END_MIX;
constexpr size_t END_CAT = OFF_CAT + (size_t)NTOK * 1280 * 2;
constexpr size_t WS_END = END_CAT > END_ACT ? END_CAT : END_ACT;

struct Params {
    const float* in[16];
    float* out;
    unsigned char* ws;
    int ph_lo, ph_hi, probe, pad;
};

#define AS1 __attribute__((address_space(1)))
#define AS4 __attribute__((address_space(4)))
template <class T> __device__ __forceinline__ T* as_global(T* p) { return (T*)(AS1 T*)p; }
#if defined(__HIP_DEVICE_COMPILE__)
__device__ __forceinline__ const AS4 Params* kp4() { const AS4 Params* kp = (const AS4 Params*)__builtin_amdgcn_kernarg_segment_ptr(); asm volatile("" : "+s"(kp)); return kp; }
#else
__device__ const AS4 Params* kp4();
#endif
__device__ __forceinline__ const float* kin(int i) { return as_global(kp4()->in[i]); }
__device__ __forceinline__ float* kout() { return as_global(kp4()->out); }
__device__ __forceinline__ unsigned char* kws() { return as_global(kp4()->ws); }
__device__ __forceinline__ int tid_now() { int t = threadIdx.x; asm volatile("" : "+v"(t)); return t; }
__device__ __forceinline__ int permk(int key) { return (key & ~31) | (((key >> 2) & 3) << 3) | (((key >> 4) & 1) << 2) | (key & 3); }
__device__ __forceinline__ unsigned pack_bf16_t(float lo, float hi) { unsigned r; asm("s_nop 0\n\tv_cvt_pk_bf16_f32 %0, %1, %2" : "=v"(r) : "v"(lo), "v"(hi)); return r; }
__device__ __forceinline__ unsigned pack_bf16(float lo, float hi) { unsigned r; asm("v_cvt_pk_bf16_f32 %0, %1, %2" : "=v"(r) : "v"(lo), "v"(hi)); return r; }
__device__ __forceinline__ float bf_lo(unsigned u) { return __uint_as_float(u << 16); }
__device__ __forceinline__ float bf_hi(unsigned u) { return __uint_as_float(u & 0xffff0000u); }
__device__ __forceinline__ float shflx(float v, int mask, int lane) { return __int_as_float(__builtin_amdgcn_ds_bpermute((lane ^ mask) << 2, __float_as_int(v))); }
template <int CTRL> __device__ __forceinline__ float dppf(float v) { return __int_as_float(__builtin_amdgcn_update_dpp(0, __float_as_int(v), CTRL, 0xF, 0xF, true)); }
__device__ __forceinline__ float wave_sum(float v, int lane) {
    v += dppf<0xB1>(v); v += dppf<0x4E>(v); v += dppf<0x141>(v); v += dppf<0x140>(v);
    const float s0 = __int_as_float(__builtin_amdgcn_readlane(__float_as_int(v), 0)), s1 = __int_as_float(__builtin_amdgcn_readlane(__float_as_int(v), 16));
    const float s2 = __int_as_float(__builtin_amdgcn_readlane(__float_as_int(v), 32)), s3 = __int_as_float(__builtin_amdgcn_readlane(__float_as_int(v), 48));
    (void)lane; return (s0 + s1) + (s2 + s3);
}

namespace pg8 {
constexpr int BM = 256, BK = 64, HALF = 128, HTB = HALF * BK * 2, STAGE_BYTES = 8 * HTB, NXCD = 8, WGM = 8;
__device__ __forceinline__ int lds_byte(int r, int c) { const int st = (r >> 4) * 2 + (c >> 5), rr = r & 15, cc = c & 31, ob = rr * 64 + cc * 2; return st * 1024 + (ob ^ (((ob >> 9) & 1) << 5)); }
__device__ __forceinline__ void stage_rc(int b, int& R, int& C) { const int st = b / 1024, sb = b % 1024, swz = sb ^ (((sb >> 9) & 1) << 5); R = (st >> 1) * 16 + swz / 64; C = (st & 1) * 32 + (swz % 64) / 2; }
struct Unit { int pm, pn; };
struct Gemm { const bf16_t* A; const bf16_t* Bt; int M, N, K; };
struct StaticOrder {
    int nM, nN, nwg, G, c;
    __device__ void init(int M, int N, int G_, int c_) { nM = M / BM; nN = N / BM; nwg = nM * nN; G = G_; c = c_; }
    __device__ bool next(int i, Unit& u) const {
        const long L = (long)i * G + c; if (L >= nwg) return false;
        int wgid = (int)L; { const int q = nwg / NXCD, r = nwg % NXCD, xcd = wgid % NXCD, off = wgid / NXCD; wgid = (xcd < r ? xcd * (q + 1) : r * (q + 1) + (xcd - r) * q) + off; }
        const int nig = WGM * nN, gid = wgid / nig, fm = gid * WGM, gsz = (nM - fm) < WGM ? (nM - fm) : WGM;
        u.pm = fm + ((wgid % nig) % gsz); u.pn = (wgid % nig) / gsz; return true;
    }
    __device__ __forceinline__ void a_ready(const Unit&) const {}
    __device__ __forceinline__ void done(const Unit&) const {}
};
struct OneUnit {
    int valid, pm, pn;
    __device__ bool next(int i, Unit& u) const { if (i != 0 || !valid) return false; u.pm = pm; u.pn = pn; return true; }
    __device__ __forceinline__ void a_ready(const Unit&) const {}
    __device__ __forceinline__ void done(const Unit&) const {}
};

template <class Epi, class Sched>
__device__ __forceinline__ void gemm_phase(LAS unsigned char* lds, const Gemm g, const Sched& S, const Epi& E) {
    const int tid = tid_now(), wid = __builtin_amdgcn_readfirstlane(tid >> 6), lane = tid & 63, wr = wid >> 2, wc = wid & 3, fr = lane & 15, fq = lane >> 4;
    const int K = g.K, nt = K / BK;
    unsigned voffA[2], voffB[2];
#pragma unroll
    for (int i = 0; i < 2; ++i) { int R, C; stage_rc(tid * 16 + i * 8192, R, C); voffA[i] = (unsigned)(R * K + C) * 2u; voffB[i] = voffA[i]; }
    const size_t kstep = (size_t)(BK * 2);
    const size_t hstep = (size_t)HALF * K * 2;
    const size_t tstep = 2 * hstep;
    const unsigned ldsw = (unsigned)wid * 1024u;
    const int aoff = lds_byte(wr * 64 + fr, fq * 8), boff = lds_byte(wc * 32 + fr, fq * 8);
#define PG8_SA(b, h) (((b) * 2 + (h)) * HTB)
#define PG8_SB(b, h) ((4 + (b) * 2 + (h)) * HTB)
#define PG8_STAGE(bufoff, gbase, voff) do { _Pragma("unroll") for (int _i = 0; _i < 2; ++_i) \
        __builtin_amdgcn_global_load_lds((const unsigned*)((const char*)(gbase) + (voff)[_i]), (LAS unsigned*)(lds + (bufoff) + ldsw + _i * 8192), 16, 0, 0); } while (0)
#define PG8_LDA(dst, b, h) do { _Pragma("unroll") for (int m = 0; m < 4; ++m) _Pragma("unroll") for (int k = 0; k < 2; ++k) dst[m][k] = *(const LAS bf16x8*)(lds + PG8_SA(b, h) + aoff + m * 2048 + k * 1024); } while (0)
#define PG8_LDB(dst, b, h) do { _Pragma("unroll") for (int n = 0; n < 2; ++n) _Pragma("unroll") for (int k = 0; k < 2; ++k) dst[n][k] = *(const LAS bf16x8*)(lds + PG8_SB(b, h) + boff + n * 2048 + k * 1024); } while (0)
#define PG8_MMA(ai, bj, At, Bt) do { __builtin_amdgcn_s_setprio(1); _Pragma("unroll") for (int m = 0; m < 4; ++m) _Pragma("unroll") for (int n = 0; n < 2; ++n) _Pragma("unroll") for (int k = 0; k < 2; ++k) \
        acc[ai][bj][m][n] = __builtin_amdgcn_mfma_f32_16x16x32_bf16(Bt[n][k], At[m][k], acc[ai][bj][m][n], 0, 0, 0); __builtin_amdgcn_s_setprio(0); } while (0)
#define PG8_WAIT_V(n) asm volatile("s_waitcnt vmcnt(" #n ")" ::: "memory")
#define PG8_WAIT_L(n) asm volatile("s_waitcnt lgkmcnt(" #n ")" ::: "memory")
#define PG8_BAR __builtin_amdgcn_s_barrier()
#define PG8_SCHED __builtin_amdgcn_sched_barrier(0)
    Unit cur, nxt; int ui = 0;
    if (!S.next(0, cur)) return;
    f32x4 acc[2][2][4][2];
#pragma unroll
    for (int a = 0; a < 2; ++a)
#pragma unroll
        for (int b = 0; b < 2; ++b)
#pragma unroll
            for (int m = 0; m < 4; ++m)
#pragma unroll
                for (int n = 0; n < 2; ++n) acc[a][b][m][n] = (f32x4){0.f, 0.f, 0.f, 0.f};
    bf16x8 At[4][2], B0[2][2], B1[2][2];
    const char* cA = (const char*)g.A + (size_t)cur.pm * tstep; const char* cB = (const char*)g.Bt + (size_t)cur.pn * tstep;
    S.a_ready(cur);
    PG8_STAGE(PG8_SB(0, 0), cB, voffB); PG8_STAGE(PG8_SA(0, 0), cA, voffA); PG8_STAGE(PG8_SB(0, 1), cB + hstep, voffB); PG8_STAGE(PG8_SA(0, 1), cA + hstep, voffA);
    if (wr == 1) PG8_BAR;
    PG8_WAIT_V(4); PG8_BAR;
    PG8_STAGE(PG8_SB(1, 0), cB + kstep, voffB); PG8_STAGE(PG8_SA(1, 0), cA + kstep, voffA); PG8_STAGE(PG8_SB(1, 1), cB + hstep + kstep, voffB);
    PG8_WAIT_V(6); PG8_BAR;
    for (;;) {
        const bool has_next = S.next(ui + 1, nxt);
        const char* nA = has_next ? (const char*)g.A + (size_t)nxt.pm * tstep : cA; const char* nB = has_next ? (const char*)g.Bt + (size_t)nxt.pn * tstep : cB;
        for (int t = 0; t < nt; t += 2) {
            const bool last = (t == nt - 2);
            const char* a1 = cA + (size_t)(t + 1) * kstep;
            const char* a2 = last ? nA : cA + (size_t)(t + 2) * kstep; const char* b2 = last ? nB : cB + (size_t)(t + 2) * kstep;
            const char* a3 = a2 + kstep; const char* b3 = b2 + kstep;
            if (last && has_next) S.a_ready(nxt);
            PG8_LDB(B0, 0, 0); PG8_SCHED; PG8_LDA(At, 0, 0); PG8_STAGE(PG8_SA(1, 1), a1 + hstep, voffA);
            PG8_WAIT_L(8); PG8_BAR; PG8_WAIT_L(0); PG8_MMA(0, 0, At, B0); PG8_BAR; PG8_SCHED;
            PG8_LDB(B1, 0, 1); PG8_STAGE(PG8_SB(0, 0), b2, voffB);
            PG8_BAR; PG8_WAIT_L(0); PG8_MMA(0, 1, At, B1); PG8_BAR;
            PG8_LDA(At, 0, 1); PG8_STAGE(PG8_SA(0, 0), a2, voffA);
            PG8_BAR; PG8_WAIT_L(0); PG8_MMA(1, 0, At, B0); PG8_BAR; PG8_SCHED;
            PG8_STAGE(PG8_SB(0, 1), b2 + hstep, voffB);
            PG8_WAIT_V(6); PG8_BAR; PG8_MMA(1, 1, At, B1); PG8_BAR;
            PG8_LDB(B0, 1, 0); PG8_SCHED; PG8_LDA(At, 1, 0); PG8_STAGE(PG8_SA(0, 1), a2 + hstep, voffA);
            PG8_WAIT_L(8); PG8_BAR; PG8_WAIT_L(0); PG8_MMA(0, 0, At, B0); PG8_BAR; PG8_SCHED;
            PG8_LDB(B1, 1, 1); PG8_STAGE(PG8_SB(1, 0), b3, voffB);
            PG8_BAR; PG8_WAIT_L(0); PG8_MMA(0, 1, At, B1); PG8_BAR;
            PG8_LDA(At, 1, 1); PG8_STAGE(PG8_SA(1, 0), a3, voffA);
            PG8_BAR; PG8_WAIT_L(0); PG8_MMA(1, 0, At, B0); PG8_BAR; PG8_SCHED;
            PG8_STAGE(PG8_SB(1, 1), b3 + hstep, voffB);
            PG8_WAIT_V(6); PG8_BAR; PG8_MMA(1, 1, At, B1); PG8_BAR;
        }
        { const int tl = tid_now(); const int ew = __builtin_amdgcn_readfirstlane(tl >> 6), el = tl & 63;
          E(acc, cur, ew >> 2, ew & 3, el & 15, el >> 4); } S.done(cur);
        if (!has_next) break;
#pragma unroll
        for (int a = 0; a < 2; ++a)
#pragma unroll
            for (int b = 0; b < 2; ++b)
#pragma unroll
                for (int m = 0; m < 4; ++m)
#pragma unroll
                    for (int n = 0; n < 2; ++n) acc[a][b][m][n] = (f32x4){0.f, 0.f, 0.f, 0.f};
        cur = nxt; cA = nA; cB = nB; ++ui;
    }
    PG8_WAIT_V(0);
    if (wr == 0) PG8_BAR;
    PG8_BAR;
#undef PG8_SA
#undef PG8_SB
#undef PG8_STAGE
#undef PG8_LDA
#undef PG8_LDB
#undef PG8_MMA
#undef PG8_WAIT_V
#undef PG8_WAIT_L
#undef PG8_BAR
#undef PG8_SCHED
}
}
using pg8::Unit;


struct EpiSwiglu {
    int dummy;
    __device__ __forceinline__ void operator()(const f32x4 (&acc)[2][2][4][2], const Unit& u, int wr, int wc, int fr, int fq) const {
        bf16_t* O = (bf16_t*)(kws() + OFF_ACT);
        const int row0 = u.pm * 256 + wr * 64 + fr, hid = 128 * u.pn + 32 * wc + 8 * fq;
#pragma unroll
        for (int ai = 0; ai < 2; ++ai)
#pragma unroll
            for (int m = 0; m < 4; ++m) {
                u32x4 pk;
#pragma unroll
                for (int bj = 0; bj < 2; ++bj) {
                    const f32x4 g = acc[ai][bj][m][0], uu = acc[ai][bj][m][1];
                    float o[4];
#pragma unroll
                    for (int j = 0; j < 4; ++j) o[j] = g[j] * __builtin_amdgcn_rcpf(1.f + __expf(-g[j])) * uu[j];
                    if (bj == 0) { pk.x = pack_bf16(o[0], o[1]); pk.y = pack_bf16(o[2], o[3]); } else { pk.z = pack_bf16(o[0], o[1]); pk.w = pack_bf16(o[2], o[3]); }
                }
                *(u32x4*)(O + (size_t)(row0 + ai * 128 + m * 16) * DFF + hid) = pk;
            }
    }
};
struct EpiY {
    int ldc;
    __device__ __forceinline__ void operator()(const f32x4 (&acc)[2][2][4][2], const Unit& u, int wr, int wc, int fr, int fq) const {
        bf16_t* O = (bf16_t*)(kws() + OFF_Y);
        const int row0 = u.pm * 256 + wr * 64 + fr, col0 = u.pn * 256 + wc * 32 + 8 * fq;
#pragma unroll
        for (int ai = 0; ai < 2; ++ai)
#pragma unroll
            for (int m = 0; m < 4; ++m) {
                bf16_t* rowp = O + (size_t)(row0 + ai * 128 + m * 16) * ldc + col0;
#pragma unroll
                for (int bj = 0; bj < 2; ++bj) {
                    const f32x4 v0 = acc[ai][bj][m][0], v1 = acc[ai][bj][m][1];
                    u32x4 pk; pk.x = pack_bf16(v0[0], v0[1]); pk.y = pack_bf16(v0[2], v0[3]); pk.z = pack_bf16(v1[0], v1[1]); pk.w = pack_bf16(v1[2], v1[3]);
                    *(u32x4*)(rowp + bj * 128) = pk;
                }
            }
    }
};
struct EpiDft {
    int tokbase, seqlen, coloff;
    __device__ __forceinline__ void operator()(const f32x4 (&acc)[2][2][4][2], const Unit& u, int wr, int wc, int fr, int fq) const {
        bf16_t* CAT = (bf16_t*)(kws() + OFF_CAT);
        const int row0 = u.pm * 256 + wr * 64 + fr; const int b = u.pn;
        const int col0 = wc * 32 + 4 * fq;
#pragma unroll
        for (int ai = 0; ai < 2; ++ai)
#pragma unroll
            for (int m = 0; m < 4; ++m) {
                bf16_t* rowp = CAT + (size_t)(tokbase + b * seqlen + row0 + ai * 128 + m * 16) * 1280 + coloff + col0;
#pragma unroll
                for (int bj = 0; bj < 2; ++bj)
#pragma unroll
                    for (int n = 0; n < 2; ++n) {
                        const f32x4 v = acc[ai][bj][m][n];
                        u32x2 pk; pk.x = pack_bf16(v[0], v[1]); pk.y = pack_bf16(v[2], v[3]);
                        *(u32x2*)(rowp + bj * 128 + n * 16) = pk;
                    }
            }
    }
};
struct EpiIn {
    int layer;
    __device__ __forceinline__ void operator()(const f32x4 (&acc)[2][2][4][2], const Unit& u, int wr, int wc, int fr, int fq) const {
        unsigned char* ws = kws(); float* outk = kout() + (size_t)2 * NCTX * 1024; float* outv = outk + (size_t)NCTX * 1024;
        const float* ropec = (const float*)(ws + OFF_ROPE); const float* ropes = ropec + 1024;
        const int pn = u.pn; const bool lat = u.pm >= 32;
        const int row0 = u.pm * 256 + wr * 64 + fr;
        if (pn < 4) {
            const bool isq = pn < 2; const int axis = wc & 1; const int mm = wc >> 1;
            const float qs = isq ? 0.125f * 1.44269504089f : 1.0f;
#pragma unroll
            for (int ai = 0; ai < 2; ++ai)
#pragma unroll
                for (int m = 0; m < 4; ++m) { __builtin_amdgcn_sched_barrier(0);
                    const int r = row0 + ai * 128 + m * 16;
                    f32x4 cs = (f32x4){1.f, 1.f, 1.f, 1.f}, sn = (f32x4){0.f, 0.f, 0.f, 0.f};
                    int b, s;
                    if (lat) { const int t = (r - NCTX) & 2047; b = (r - NCTX) >> 11; s = t; const int pos = axis ? (t & 63) : (t >> 6);
                        cs = *(const f32x4*)(ropec + pos * 16 + 4 * fq); sn = *(const f32x4*)(ropes + pos * 16 + 4 * fq); }
                    else { b = r >> 8; s = r & 255; }
#pragma unroll
                    for (int bj = 0; bj < 2; ++bj) {
                        const int h = 2 * (pn & 1) + bj;
                        const f32x4 x1 = acc[ai][bj][m][0], x2 = acc[ai][bj][m][1];
                        f32x4 y1, y2;
#pragma unroll
                        for (int j = 0; j < 4; ++j) { y1[j] = (x1[j] * cs[j] - x2[j] * sn[j]) * qs; y2[j] = (x2[j] * cs[j] + x1[j] * sn[j]) * qs; }
                        const int cc = mm * 64 + axis * 32 + 4 * fq;
                        u32x2 p1, p2; p1.x = pack_bf16(y1[0], y1[1]); p1.y = pack_bf16(y1[2], y1[3]); p2.x = pack_bf16(y2[0], y2[1]); p2.y = pack_bf16(y2[2], y2[3]);
                        if (isq) {
                            bf16_t* qp = (bf16_t*)(ws + OFF_Q) + (size_t)r * 512 + h * 128 + cc;
                            *(u32x2*)qp = p1; *(u32x2*)(qp + 16) = p2;
                        } else {
                            bf16_t* kp = lat ? (bf16_t*)(ws + OFF_KL) + ((size_t)(b * 4 + h) * 2560 + s) * 128 + cc
                                             : (bf16_t*)(ws + OFF_KC) + ((size_t)(b * 4 + h) * 256 + s) * 128 + cc;
                            *(u32x2*)kp = p1; *(u32x2*)(kp + 16) = p2;
                            if (!lat) { float* ok = outk + ((size_t)(b * 2 + layer) * 256 + s) * 512 + h * 128 + cc; *(f32x4*)ok = x1; *(f32x4*)(ok + 16) = x2; }
                        }
                    }
                }
        } else if (pn < 6) {
#pragma unroll
            for (int ai = 0; ai < 2; ++ai)
#pragma unroll
                for (int m = 0; m < 4; ++m) { __builtin_amdgcn_sched_barrier(0);
                    const int r = row0 + ai * 128 + m * 16;
                    int b, s; if (lat) { b = (r - NCTX) >> 11; s = (r - NCTX) & 2047; } else { b = r >> 8; s = r & 255; }
#pragma unroll
                    for (int bj = 0; bj < 2; ++bj) {
                        const int h = 2 * (pn & 1) + bj;
#pragma unroll
                        for (int n = 0; n < 2; ++n) {
                            const f32x4 v = acc[ai][bj][m][n]; const int e = wc * 32 + n * 16 + 4 * fq;
                            bf16_t* vp = lat ? (bf16_t*)(ws + OFF_VTL) + ((size_t)(b * 4 + h) * 128 + e) * 2560 + permk(s)
                                             : (bf16_t*)(ws + OFF_VTC) + ((size_t)(b * 4 + h) * 128 + e) * 256 + permk(s);
                            const int ldv = lat ? 2560 : 256;
                            const unsigned p01 = pack_bf16(v[0], v[1]), p23 = pack_bf16(v[2], v[3]);
                            {
                                const int odd = fr & 1; const unsigned mine = odd ? p23 : p01, send = odd ? p01 : p23;
                                const unsigned recv = (unsigned)__builtin_amdgcn_update_dpp(0, (int)send, 0xB1, 0xF, 0xF, true);
                                const unsigned w0 = odd ? ((recv & 0xffffu) | (mine << 16)) : ((mine & 0xffffu) | (recv << 16));
                                const unsigned w1 = odd ? ((recv >> 16) | (mine & 0xffff0000u)) : ((mine >> 16) | (recv & 0xffff0000u));
                                bf16_t* vq = vp + (odd ? 2 * ldv - 1 : 0);
                                *(unsigned*)vq = w0; *(unsigned*)(vq + ldv) = w1; }
                            if (!lat) *(f32x4*)(outv + ((size_t)(b * 2 + layer) * 256 + s) * 512 + h * 128 + e) = v;
                        }
                    }
                }
        } else if (pn < 9) {
            bf16_t* base = (bf16_t*)(ws + OFF_CONV) + (size_t)(pn - 6) * NTOK * 256;
#pragma unroll
            for (int ai = 0; ai < 2; ++ai)
#pragma unroll
                for (int m = 0; m < 4; ++m) { __builtin_amdgcn_sched_barrier(0);
                    bf16_t* rowp = base + (size_t)(row0 + ai * 128 + m * 16) * 256 + wc * 32 + 8 * fq;
#pragma unroll
                    for (int bj = 0; bj < 2; ++bj) {
                        const f32x4 v0 = acc[ai][bj][m][0], v1 = acc[ai][bj][m][1];
                        u32x4 pk; pk.x = pack_bf16(v0[0], v0[1]); pk.y = pack_bf16(v0[2], v0[3]); pk.z = pack_bf16(v1[0], v1[1]); pk.w = pack_bf16(v1[2], v1[3]);
                        *(u32x4*)(rowp + bj * 128) = pk;
                    }
                }
        } else {
            const int part = pn - 9;
#pragma unroll
            for (int ai = 0; ai < 2; ++ai)
#pragma unroll
                for (int m = 0; m < 4; ++m) { __builtin_amdgcn_sched_barrier(0);
                    const int r = row0 + ai * 128 + m * 16;
                    int b, s; if (lat) { b = (r - NCTX) >> 11; s = (r - NCTX) & 2047; } else { b = r >> 8; s = r & 255; }
#pragma unroll
                    for (int bj = 0; bj < 2; ++bj)
#pragma unroll
                        for (int n = 0; n < 2; ++n) {
                            const f32x4 v = acc[ai][bj][m][n]; const int c = bj * 128 + wc * 32 + n * 16 + 4 * fq;
                            const int ldf = lat ? 2048 : 256;
                            bf16_t* fp = lat ? (bf16_t*)(ws + OFF_FTL) + (size_t)part * 1024 * 2048 + (size_t)(b * 256 + c) * 2048 + s
                                             : (bf16_t*)(ws + OFF_FTC) + (size_t)part * 8192 * 256 + (size_t)(b * 256 + c) * 256 + s;
                            const unsigned p01 = pack_bf16(v[0], v[1]), p23 = pack_bf16(v[2], v[3]);
                            {
                                const int odd = fr & 1; const unsigned mine = odd ? p23 : p01, send = odd ? p01 : p23;
                                const unsigned recv = (unsigned)__builtin_amdgcn_update_dpp(0, (int)send, 0xB1, 0xF, 0xF, true);
                                const unsigned w0 = odd ? ((recv & 0xffffu) | (mine << 16)) : ((mine & 0xffffu) | (recv << 16));
                                const unsigned w1 = odd ? ((recv >> 16) | (mine & 0xffff0000u)) : ((mine >> 16) | (recv & 0xffff0000u));
                                bf16_t* fq2 = fp + (odd ? 2 * ldf - 1 : 0);
                                *(unsigned*)fq2 = w0; *(unsigned*)(fq2 + ldf) = w1; }
                        }
                }
        }
    }
};

__device__ __forceinline__ int srccol_gu(int np) { const int pn = np >> 8, bj = (np >> 7) & 1, wc = (np >> 5) & 3, n = (np >> 4) & 1, i = np & 15;
    const int hid = 128 * pn + 32 * wc + 8 * (i >> 2) + 4 * bj + (i & 3); return n ? 2816 + hid : hid; }

__device__ __forceinline__ void xpose_tile(LAS float* tile, const float* src, int ld, int k0, int np0, int mode, int kd0, bf16_t* dst, int K) {
    const int tid = tid_now();
    { const int j4 = (tid & 63) * 4, kb = tid >> 6; const int npj = np0 + j4; const int sc = mode == 1 ? srccol_gu(npj) : (mode == 2 ? (npj & ~31) + 8 * ((npj & 15) >> 2) + 4 * ((npj >> 4) & 1) + (npj & 3) : npj);
      f32x4 v[8];
#pragma unroll
      for (int i = 0; i < 8; ++i) v[i] = *(const f32x4*)(src + (size_t)(k0 + kb + 8 * i) * ld + sc);
#pragma unroll
      for (int i = 0; i < 8; ++i) { LAS float* t = tile + (kb + 8 * i) * 257 + j4; t[0] = v[i][0]; t[1] = v[i][1]; t[2] = v[i][2]; t[3] = v[i][3]; } }
    __syncthreads();
    { const int kg = (tid & 7) * 8, nb = tid >> 3;
#pragma unroll
      for (int i = 0; i < 4; ++i) { const int n = nb + 64 * i; const LAS float* t = tile + kg * 257 + n;
          u32x4 pk; pk.x = pack_bf16(t[0], t[257]); pk.y = pack_bf16(t[2 * 257], t[3 * 257]); pk.z = pack_bf16(t[4 * 257], t[5 * 257]); pk.w = pack_bf16(t[6 * 257], t[7 * 257]);
          *(u32x4*)(dst + (size_t)(np0 + n) * K + kd0 + kg) = pk; } }
    __syncthreads();
}

__device__ __forceinline__ void prep_phase(LAS float* lds, int stage, int rank, int nblk) {
    const int tid = tid_now();
    unsigned char* ws = kws();
    constexpr int J_WGU = 4 * 16 * 22, J_WDN = 4 * 44 * 4, J_WIN = 2 * 16 * 9, J_FCS = 2 * 16 * 8, J_WOUT = 2 * 20 * 4, J_MOD = 144, J_DL = 256, J_DC = 8, J_MISC = 1;
    constexpr int E1 = J_WGU, E2 = E1 + J_WDN, E3 = E2 + J_WIN, E4 = E3 + J_FCS, E5 = E4 + J_WOUT, E6 = E5 + J_MOD, E7 = E6 + J_DL, E8 = E7 + J_DC, E9 = E8 + J_MISC;
    int s0, n0, s1, n1, s2, n2, s3, n3, s4, n4, s5, n5;
    if (stage == 0)      { s0 = E5; n0 = 72; s1 = E8; n1 = 1; s2 = 0; n2 = 0; s3 = 0; n3 = 0; s4 = 0; n4 = 0; s5 = 0; n5 = 0; }
    else if (stage == 5) { s0 = 0; n0 = 352; s1 = E5 + 72; n1 = 72; s2 = E6; n2 = E8 - E6; s3 = 0; n3 = 0; s4 = 0; n4 = 0; s5 = 0; n5 = 0; }
    else if (stage == 1) { s0 = E1; n0 = 176; s1 = E2; n1 = 144; s2 = E3; n2 = 128; s3 = 352; n3 = 352; s4 = 0; n4 = 0; s5 = 0; n5 = 0; }
    else if (stage == 2) { s0 = E1 + 176; n0 = 176; s1 = 704; n1 = 352; s2 = E2 + 144; n2 = 144; s3 = E3 + 128; n3 = 128; s4 = 0; n4 = 0; s5 = 0; n5 = 0; }
    else if (stage == 4) { s0 = 1056; n0 = 352; s1 = E1 + 528; n1 = 176; s2 = 0; n2 = 0; s3 = 0; n3 = 0; s4 = 0; n4 = 0; s5 = 0; n5 = 0; }
    else                 { s0 = E4; n0 = 160; s1 = E1 + 352; n1 = 176; s2 = 0; n2 = 0; s3 = 0; n3 = 0; s4 = 0; n4 = 0; s5 = 0; n5 = 0; }
    const int ntot = n0 + n1 + n2 + n3 + n4 + n5;
    for (int lj = rank; lj < ntot; lj += nblk) {
        int job, r = lj;
        if (r < n0) job = s0 + r; else { r -= n0;
        if (r < n1) job = s1 + r; else { r -= n1;
        if (r < n2) job = s2 + r; else { r -= n2;
        if (r < n3) job = s3 + r; else { r -= n3;
        if (r < n4) job = s4 + r; else { r -= n4; job = s5 + r; } } } } }
        if (job < E1) {
            const int mat = job / (16 * 22), r = job % (16 * 22), kt = r / 22, nt = r % 22;
            xpose_tile(lds, kin(9) + (size_t)mat * 1024 * 5632, 5632, kt * 64, nt * 256, 1, kt * 64, (bf16_t*)(ws + OFF_WGU + mat * SZ_WGU), 1024);
        } else if (job < E2) {
            const int j = job - E1; const int mat = j / (44 * 4), r = j % (44 * 4), kt = r / 4, nt = r % 4;
            xpose_tile(lds, kin(10) + (size_t)mat * 2816 * 1024, 1024, kt * 64, nt * 256, 2, kt * 64, (bf16_t*)(ws + OFF_WDN + mat * SZ_WDN), 2816);
        } else if (job < E3) {
            const int j = job - E2; const int mat = j / (16 * 9), r = j % (16 * 9), kt = r / 9, nt = r % 9;
            xpose_tile(lds, kin(11) + (size_t)mat * 1024 * 2560, 2560, kt * 64, nt * 256, nt >= 6 ? 2 : 0, kt * 64, (bf16_t*)(ws + OFF_WIN + mat * SZ_WIN), 1024);
        } else if (job < E4) {
            const int j = job - E3; const int mat = j / 128, r = j % 128, kt = r / 8, gsel = r % 8, g = gsel >> 1, sn = gsel & 1;
            const float* src = kin(11) + (size_t)mat * 1024 * 2560; const int k0 = kt * 64;
            LAS float* tile = lds; LAS float* tw = lds + 64 * 65;
            { const int jj = tid & 63, kb = tid >> 6; float tv[8];
#pragma unroll
              for (int i = 0; i < 8; ++i) tv[i] = src[(size_t)(k0 + kb + 8 * i) * 2560 + 2304 + g * 64 + jj];
              __builtin_amdgcn_sched_barrier(0);
#pragma unroll
              for (int i = 0; i < 8; ++i) tile[(kb + 8 * i) * 65 + jj] = tv[i]; }
            if (tid < 64) tw[tid] = (sn ? sinpif((float)tid / 32.f) : cospif((float)tid / 32.f)) * 0.125f;
            __syncthreads();
            bf16_t* dst = (bf16_t*)(ws + OFF_WIN + mat * SZ_WIN);
            { const int kk2 = (tid & 31) * 2, cb = tid >> 5;
#pragma unroll 1
              for (int i = 0; i < 4; ++i) { const int cc = cb + 16 * i; float v0 = 0.f, v1 = 0.f;
#pragma unroll 4
                  for (int c2 = 0; c2 < 64; ++c2) { const float w = tw[(c2 * cc) & 63]; v0 += tile[kk2 * 65 + c2] * w; v1 += tile[(kk2 + 1) * 65 + c2] * w; }
                  *(unsigned*)(dst + (size_t)(2304 + sn * 256 + g * 64 + cc) * 1024 + k0 + kk2) = pack_bf16(v0, v1); } }
            __syncthreads();
        } else if (job < E5) {
            const int j = job - E4; const int mat = j / 80, r = j % 80, kt = r / 4, nt = r % 4;
            xpose_tile(lds, kin(12) + (size_t)mat * 1024 * 1024, 1024, kt < 16 ? kt * 64 : 768 + (kt - 16) * 64, nt * 256, 2, kt * 64, (bf16_t*)(ws + OFF_WOUT + mat * SZ_WOUT), 1280);
        } else if (job < E6) {
            const int j = job - E5; const int l = j / 72, col0 = (j % 72) * 128;
            LAS float* sl = lds;
            LAS float* red = lds + 5 * 1024;
            { float cv[10]; const float* c4p = kin(4); const float* c5p = kin(5);
#pragma unroll
              for (int q = 0; q < 10; ++q) { const int i = tid + 512 * q, v = i >> 10, k = i & 1023; cv[q] = v == 0 ? c5p[k] : c4p[(v - 1) * 1024 + k]; }
              __builtin_amdgcn_sched_barrier(0);
#pragma unroll
              for (int q = 0; q < 10; ++q) sl[tid + 512 * q] = cv[q] / (1.f + __expf(-cv[q])); }
            __syncthreads();
            const int cgp = tid & 31, kc = tid >> 5;
            f32x4 a[5];
#pragma unroll
            for (int v = 0; v < 5; ++v) a[v] = (f32x4){0.f, 0.f, 0.f, 0.f};
            const float* wp = kin(6) + (size_t)l * 1024 * 9216 + col0 + 4 * cgp;
#pragma unroll 4
            for (int kk = 0; kk < 64; ++kk) { const int k = kc * 64 + kk; const f32x4 w = *(const f32x4*)(wp + (size_t)k * 9216);
#pragma unroll
                for (int v = 0; v < 5; ++v) { const float s = sl[v * 1024 + k]; a[v] += w * s; } }
#pragma unroll
            for (int v = 0; v < 5; ++v) *(LAS f32x4*)(red + (kc * 5 + v) * 128 + 4 * cgp) = a[v];
            __syncthreads();
            const float* bmp = kin(7);
            for (int i = tid; i < 5 * 128; i += 512) { const int v = i / 128, cc = i % 128; float s = bmp[l * 9216 + col0 + cc];
                for (int q = 0; q < 16; ++q) s += red[(q * 5 + v) * 128 + cc];
                ((float*)(ws + OFF_MOD))[(size_t)(l * 5 + v) * 9216 + col0 + cc] = s; }
            __syncthreads();
        } else if (job < E7) {
            const int j = job - E6; bf16_t* D = (bf16_t*)(ws + OFF_DLAT); const float sc = 0.02209708691f;
            LAS float* tc = lds; LAS float* tsn = lds + 2048;
#pragma unroll 1
            for (int i = tid; i < 2048; i += 512) { float sv, cv; sincospif((float)i * (1.f / 1024.f), &sv, &cv); tc[i] = cv * sc; tsn[i] = -sv * sc; }
            __syncthreads();
#pragma unroll 2
            for (int i = tid; i < 8 * 1024; i += 512) { const int np = j * 8 + (i >> 10), n = (i & 1023) * 2;
                const int m0 = (np * n) & 2047, m1 = (np * (n + 1)) & 2047;
                *(unsigned*)(D + (size_t)np * 2048 + n) = pack_bf16(tc[m0], tc[m1]);
                *(unsigned*)(D + (size_t)2048 * 2048 + (size_t)np * 2048 + n) = pack_bf16(tsn[m0], tsn[m1]); }
            __syncthreads();
        } else if (job < E8) {
            const int j = job - E7; bf16_t* D = (bf16_t*)(ws + OFF_DCTX); const float sc = 0.0625f;
#pragma unroll 1
            for (int i = tid; i < 32 * 128; i += 512) { const int np = j * 32 + (i >> 7), n = (i & 127) * 2;
                const int m0 = (np * n) & 255, m1 = (np * (n + 1)) & 255;
                float s0, c0, s1, c1; sincospif((float)m0 * (1.f / 128.f), &s0, &c0); sincospif((float)m1 * (1.f / 128.f), &s1, &c1);
                *(unsigned*)(D + (size_t)np * 256 + n) = pack_bf16(c0 * sc, c1 * sc);
                *(unsigned*)(D + (size_t)256 * 256 + (size_t)np * 256 + n) = pack_bf16(-s0 * sc, -s1 * sc); }
        } else {
            float* rc = (float*)(ws + OFF_ROPE); float* rs = rc + 1024;
#pragma unroll 1
            for (int i = tid; i < 1024; i += 512) { const int pos = i >> 4, f = i & 15; const float inv = 1.0f / powf(10000.0f, (float)f / 16.0f); const float ang = (float)pos * inv; rc[i] = cosf(ang); rs[i] = sinf(ang); }
            if (tid < 2) { const float* lq = kin(14) + tid * 256; float d0 = 0.f, d1 = 0.f; for (int i = 0; i < 64; ++i) { d0 += lq[i] * lq[64 + i]; d1 += lq[128 + i] * lq[192 + i]; }
                const float li = 0.8f - 0.6f * expf(-0.3f * (float)tid); ((float*)(ws + OFF_MISC))[tid] = expf(d0) - expf(d1) + li; ((float*)(ws + OFF_MISC))[2 + tid] = li; }
        }
    }
}

__device__ __forceinline__ void unpack8(const u32x4 a, f32x4& lo, f32x4& hi) { lo = (f32x4){bf_lo(a.x), bf_hi(a.x), bf_lo(a.y), bf_hi(a.y)}; hi = (f32x4){bf_lo(a.z), bf_hi(a.z), bf_lo(a.w), bf_hi(a.w)}; }
__device__ __forceinline__ u32x4 pack8(const f32x4 lo, const f32x4 hi) { u32x4 p; p.x = pack_bf16(lo[0], lo[1]); p.y = pack_bf16(lo[2], lo[3]); p.z = pack_bf16(hi[0], hi[1]); p.w = pack_bf16(hi[2], hi[3]); return p; }
__device__ __forceinline__ void row_phase(int lprev, int sprev, float rw, int lnext, int snext) {
    const int tid = tid_now(), wave = tid >> 6, lane = tid & 63;
    float* XO = kout(); unsigned char* ws = kws();
    const bf16_t* Y = (const bf16_t*)(ws + OFF_Y); bf16_t* H = (bf16_t*)(ws + OFF_H); bf16_t* XB = (bf16_t*)(ws + OFF_XB);
    const float* MOD = (const float*)(ws + OFF_MOD); const float* NG = kin(8);
    const float* xin0 = kin(0); const float* xin1 = kin(1);
    const int nwave = gridDim.x * 8, RW = NTOK / nwave, gw = blockIdx.x * 8 + wave;
    const int rbase = gw * RW;
    const int v = rbase < NCTX ? 0 : 1 + ((rbase - NCTX) >> 11);
    f32x4 vgate[4], vgpost[4], vsh[4], vsc[4], vgpre[4];
    if (lprev >= 0) { const float* gate = MOD + (size_t)(lprev * 5 + v) * 9216 + (3 * sprev + 2) * 1024; const float* gp = NG + (lprev * 6 + 2 * sprev + 1) * 1024;
#pragma unroll
        for (int q = 0; q < 4; ++q) { const int col = 512 * (q >> 1) + 8 * lane + 4 * (q & 1); vgate[q] = *(const f32x4*)(gate + col) * rw; vgpost[q] = *(const f32x4*)(gp + col); } }
    if (lnext >= 0) { const float* sh = MOD + (size_t)(lnext * 5 + v) * 9216 + (3 * snext) * 1024; const float* scp = sh + 1024; const float* gp = NG + (lnext * 6 + 2 * snext) * 1024;
#pragma unroll
        for (int q = 0; q < 4; ++q) { const int col = 512 * (q >> 1) + 8 * lane + 4 * (q & 1); vsh[q] = *(const f32x4*)(sh + col); vsc[q] = *(const f32x4*)(scp + col) + 1.f; vgpre[q] = *(const f32x4*)(gp + col); } }
    for (int j = 0; j < RW; j += 2) {
        int rows[2]; rows[0] = rbase + j; rows[1] = j + 1 < RW ? rbase + j + 1 : rbase + j;
        f32x4 x[2][4], y[2][4];
        u32x4 rx[2][2], ry[2][2];
#pragma unroll
        for (int u = 0; u < 2; ++u) {
            const int row = rows[u];
            if (lprev < 0) { const float* src = row < NCTX ? xin0 + (size_t)row * 1024 : xin1 + (size_t)(row - NCTX) * 1024;
#pragma unroll
                for (int q = 0; q < 4; ++q) x[u][q] = *(const f32x4*)(src + 512 * (q >> 1) + 8 * lane + 4 * (q & 1));
            } else {
#pragma unroll
                for (int i = 0; i < 2; ++i) rx[u][i] = *(const u32x4*)(XB + (size_t)row * 1024 + 512 * i + 8 * lane);
#pragma unroll
                for (int i = 0; i < 2; ++i) ry[u][i] = *(const u32x4*)(Y + (size_t)row * 1024 + 512 * i + 8 * lane);
            }
        }
        __builtin_amdgcn_sched_barrier(0);
        if (lprev >= 0) {
#pragma unroll
            for (int u = 0; u < 2; ++u)
#pragma unroll
                for (int i = 0; i < 2; ++i) { unpack8(rx[u][i], x[u][2 * i], x[u][2 * i + 1]); unpack8(ry[u][i], y[u][2 * i], y[u][2 * i + 1]); }
        }
#pragma unroll
        for (int u = 0; u < 2; ++u) {
            const int row = rows[u];
            if (lprev >= 0) {
                float ss = 0.f;
#pragma unroll
                for (int q = 0; q < 4; ++q) ss += y[u][q][0] * y[u][q][0] + y[u][q][1] * y[u][q][1] + y[u][q][2] * y[u][q][2] + y[u][q][3] * y[u][q][3];
                ss = wave_sum(ss, lane); const float r = rsqrtf(ss * (1.f / 1024.f) + 1e-6f);
#pragma unroll
                for (int q = 0; q < 4; ++q) x[u][q] += vgate[q] * (y[u][q] * r * vgpost[q]);
            }
            if (lnext < 0) {
#pragma unroll
                for (int q = 0; q < 4; ++q) *(f32x4*)(XO + (size_t)row * 1024 + 512 * (q >> 1) + 8 * lane + 4 * (q & 1)) = x[u][q];
            } else {
#pragma unroll
                for (int i = 0; i < 2; ++i) *(u32x4*)(XB + (size_t)row * 1024 + 512 * i + 8 * lane) = pack8(x[u][2 * i], x[u][2 * i + 1]);
                float ss = 0.f;
#pragma unroll
                for (int q = 0; q < 4; ++q) ss += x[u][q][0] * x[u][q][0] + x[u][q][1] * x[u][q][1] + x[u][q][2] * x[u][q][2] + x[u][q][3] * x[u][q][3];
                ss = wave_sum(ss, lane); const float r = rsqrtf(ss * (1.f / 1024.f) + 1e-6f);
                f32x4 h[4];
#pragma unroll
                for (int q = 0; q < 4; ++q) h[q] = x[u][q] * r * vgpre[q] * vsc[q] + vsh[q];
#pragma unroll
                for (int i = 0; i < 2; ++i) *(u32x4*)(H + (size_t)row * 1024 + 512 * i + 8 * lane) = pack8(h[2 * i], h[2 * i + 1]);
            }
        }
    }
}

__device__ __forceinline__ void cache_convert(int l, LAS unsigned char* lds) {
    unsigned char* ws = kws(); const int tid = tid_now(); const int gt = blockIdx.x * 512 + tid, gs = gridDim.x * 512;
    bf16_t* KL = (bf16_t*)(ws + OFF_KL); bf16_t* VTL = (bf16_t*)(ws + OFF_VTL);
    const float* ckp = kin(2); const float* cvp = kin(3);
    for (int i = gt; i < 4 * 512 * 4 * 32; i += gs) {
        const int c4 = i & 31, h = (i >> 5) & 3, s = (i >> 7) & 511, b = i >> 16;
        const f32x4 v = *(const f32x4*)(ckp + ((((size_t)b * 2 + l) * 512 + s) * 4 + h) * 128 + c4 * 4);
        u32x2 pk; pk.x = pack_bf16(v[0], v[1]); pk.y = pack_bf16(v[2], v[3]);
        *(u32x2*)(KL + ((size_t)(b * 4 + h) * 2560 + 2048 + s) * 128 + c4 * 4) = pk;
    }
    constexpr int S = 136;
    for (int job = blockIdx.x; job < 128; job += gridDim.x) {
        const int kt = job & 7, h = (job >> 3) & 3, b = job >> 5;
        const int e4 = tid & 31, kb = tid >> 5;
        __syncthreads();
        f32x4 rv[4];
#pragma unroll
        for (int i = 0; i < 4; ++i) rv[i] = *(const f32x4*)(cvp + ((((size_t)b * 2 + l) * 512 + kt * 64 + kb + 16 * i) * 4 + h) * 128 + e4 * 4);
        __builtin_amdgcn_sched_barrier(0);
#pragma unroll
        for (int i = 0; i < 4; ++i) { const int key = kb + 16 * i;
            const f32x4 v = rv[i];
            const unsigned p01 = pack_bf16(v[0], v[1]), p23 = pack_bf16(v[2], v[3]);
            LAS unsigned char* t0 = lds + (4 * e4) * S + key * 2;
            *(LAS bf16_t*)t0 = (bf16_t)(p01 & 0xffff); *(LAS bf16_t*)(t0 + S) = (bf16_t)(p01 >> 16); *(LAS bf16_t*)(t0 + 2 * S) = (bf16_t)(p23 & 0xffff); *(LAS bf16_t*)(t0 + 3 * S) = (bf16_t)(p23 >> 16); }
        __syncthreads();
        { const int e = tid >> 2, q = tid & 3; const LAS unsigned char* r = lds + e * S + q * 32;
          bf16_t* dst = VTL + ((size_t)(b * 4 + h) * 128 + e) * 2560 + 2048 + kt * 64 + 32 * (q >> 1) + 4 * (q & 1);
#pragma unroll
          for (int g = 0; g < 4; ++g) *(u32x2*)(dst + 8 * g) = *(const LAS u32x2*)(r + g * 8); }
    }
}

constexpr int KSTR = 272, VSTR = 128;
constexpr int KT_BYTES = 64 * KSTR, VT_BYTES = 128 * VSTR;

__device__ __forceinline__ void attn_item(int item, int layer, LAS unsigned char* lds) {
    const int tid = tid_now(), wave = tid >> 6, lane = tid & 63, fr = lane & 15, g = lane >> 4;
    unsigned char* ws = kws();
    const bool lat = item < 256;
    int b, h, qb; if (lat) { b = item >> 6; h = (item >> 4) & 3; qb = item & 15; } else { const int j = item - 256; b = j >> 3; h = (j >> 1) & 3; qb = j & 1; }
    const int L = lat ? 2560 : 256, seq = lat ? 2048 : 256;
    const int tokb = lat ? NCTX + b * 2048 : b * 256;
    const int tok0 = tokb + qb * 128;
    const bf16_t* Kb = lat ? (const bf16_t*)(ws + OFF_KL) + (size_t)(b * 4 + h) * 2560 * 128 : (const bf16_t*)(ws + OFF_KC) + (size_t)(b * 4 + h) * 256 * 128;
    const bf16_t* Vb = lat ? (const bf16_t*)(ws + OFF_VTL) + (size_t)(b * 4 + h) * 128 * 2560 : (const bf16_t*)(ws + OFF_VTC) + (size_t)(b * 4 + h) * 128 * 256;
    const float lam = ((const float*)(ws + OFF_MISC))[layer], lam_init = ((const float*)(ws + OFF_MISC))[2 + layer];
    bf16_t* CAT = (bf16_t*)(ws + OFF_CAT);

    {
        const bf16_t* GB = (const bf16_t*)(ws + OFF_CONV); const bf16_t* GC = GB + (size_t)NTOK * 256; const bf16_t* HC = GC + (size_t)NTOK * 256;
        const float* cw = kin(13) + layer * 768;
        const int c4 = (tid & 15) * 4 + h * 64, tb = tid >> 4;
        const f32x4 w0 = *(const f32x4*)(cw + c4), w1 = *(const f32x4*)(cw + 256 + c4), w2 = *(const f32x4*)(cw + 512 + c4);
#pragma unroll
        for (int i = 0; i < 4; ++i) {
            const int tl = qb * 128 + tb + 32 * i;
            const size_t t = (size_t)(tokb + tl);
            f32x4 um = (f32x4){0.f, 0.f, 0.f, 0.f}, up = um, u0;
            { const u32x2 a = *(const u32x2*)(GC + t * 256 + c4), c = *(const u32x2*)(HC + t * 256 + c4);
              u0 = (f32x4){bf_lo(a.x) * bf_lo(c.x), bf_hi(a.x) * bf_hi(c.x), bf_lo(a.y) * bf_lo(c.y), bf_hi(a.y) * bf_hi(c.y)}; }
            if (tl > 0) { const u32x2 a = *(const u32x2*)(GC + (t - 1) * 256 + c4), c = *(const u32x2*)(HC + (t - 1) * 256 + c4);
              um = (f32x4){bf_lo(a.x) * bf_lo(c.x), bf_hi(a.x) * bf_hi(c.x), bf_lo(a.y) * bf_lo(c.y), bf_hi(a.y) * bf_hi(c.y)}; }
            if (tl < seq - 1) { const u32x2 a = *(const u32x2*)(GC + (t + 1) * 256 + c4), c = *(const u32x2*)(HC + (t + 1) * 256 + c4);
              up = (f32x4){bf_lo(a.x) * bf_lo(c.x), bf_hi(a.x) * bf_hi(c.x), bf_lo(a.y) * bf_lo(c.y), bf_hi(a.y) * bf_hi(c.y)}; }
            const u32x2 gbu = *(const u32x2*)(GB + t * 256 + c4);
            const f32x4 gbv = (f32x4){bf_lo(gbu.x), bf_hi(gbu.x), bf_lo(gbu.y), bf_hi(gbu.y)};
            const f32x4 o = gbv * (um * w0 + u0 * w1 + up * w2);
            u32x2 pk; pk.x = pack_bf16(o[0], o[1]); pk.y = pack_bf16(o[2], o[3]);
            *(u32x2*)(CAT + t * 1280 + 512 + c4) = pk;
        }
    }

    if (wave < 4) __builtin_amdgcn_s_setprio(2); else __builtin_amdgcn_s_setprio(0);
    const int qtok = tok0 + wave * 16 + fr;
    bf16x8 qf[2][2];
#pragma unroll
    for (int m = 0; m < 2; ++m)
#pragma unroll
        for (int ks = 0; ks < 2; ++ks) qf[m][ks] = *(const bf16x8*)((const bf16_t*)(ws + OFF_Q) + (size_t)qtok * 512 + h * 128 + m * 64 + ks * 32 + g * 8);

    LAS unsigned char* Kt[2] = {lds, lds + KT_BYTES};
    LAS unsigned char* Vt[2] = {lds + 2 * KT_BYTES, lds + 2 * KT_BYTES + VT_BYTES};
    const int skey = tid >> 3, sseg = tid & 7;
    const int ve = tid >> 2, vseg = tid & 3;
    const int vsw = (ve >> 1) & 7;
    const int vw0 = ve * 128 + (((2 * vseg) ^ vsw) << 4), vw1 = ve * 128 + (((2 * vseg + 1) ^ vsw) << 4);
    const int kro = fr * KSTR + g * 16;
    const int rsw = (fr >> 1) & 7;
    const int vro0 = fr * 128 + ((g ^ rsw) << 4), vro1 = fr * 128 + (((4 + g) ^ rsw) << 4);
    const int ntile = L / 64;

#define ATT_RDK(dst, base, c2) do { _Pragma("unroll") for (int sub = 0; sub < 2; ++sub) _Pragma("unroll") for (int m = 0; m < 2; ++m) _Pragma("unroll") for (int ks = 0; ks < 2; ++ks) \
        dst[sub][m][ks] = *(const LAS bf16x8*)((base) + ((c2) * 2 + sub) * 16 * KSTR + kro + m * 128 + ks * 64); } while (0)
#define ATT_QK(sdst, kf, i0_, i1_) do { _Pragma("unroll") for (int sub = 0; sub < 2; ++sub) _Pragma("unroll") for (int m = 0; m < 2; ++m) { f32x4 a_ = m ? i1_ : i0_; \
        _Pragma("unroll") for (int ks = 0; ks < 2; ++ks) a_ = __builtin_amdgcn_mfma_f32_16x16x32_bf16(kf[sub][m][ks], qf[m][ks], a_, 0, 0, 0); sdst[m][sub] = a_; } } while (0)

    float mrun[2] = {-INFINITY, -INFINITY};
    const f32x4 zero4 = (f32x4){0.f, 0.f, 0.f, 0.f};
#define ATT_LDK(k0_, k1_, tt) do { const bf16_t* src_ = Kb + (size_t)((tt) * 64 + skey) * 128 + sseg * 16; k0_ = *(const u32x4*)src_; k1_ = *(const u32x4*)(src_ + 8); } while (0)
#define ATT_WRK(k0_, k1_, bi) do { LAS unsigned char* d_ = Kt[bi] + skey * KSTR + sseg * 32; *(LAS u32x4*)d_ = k0_; *(LAS u32x4*)(d_ + 16) = k1_; } while (0)
#define ATT_P1(bi) do { const LAS unsigned char* kt_ = Kt[bi]; \
            bf16x8 kfA[2][2][2], kfB[2][2][2]; ATT_RDK(kfA, kt_, 0); ATT_RDK(kfB, kt_, 1); __builtin_amdgcn_sched_barrier(0); \
            f32x4 sA[2][2], sB[2][2]; ATT_QK(sA, kfA, zero4, zero4); ATT_QK(sB, kfB, zero4, zero4); __builtin_amdgcn_sched_barrier(0); \
            _Pragma("unroll") for (int m = 0; m < 2; ++m) { \
                    const f32x4 v0 = sA[m][0], v1 = sA[m][1], v2 = sB[m][0], v3 = sB[m][1]; \
                    const float t0 = fmaxf(fmaxf(fmaxf(v0[0], v0[1]), fmaxf(v0[2], v0[3])), fmaxf(fmaxf(v1[0], v1[1]), fmaxf(v1[2], v1[3]))); \
                    const float t1 = fmaxf(fmaxf(fmaxf(v2[0], v2[1]), fmaxf(v2[2], v2[3])), fmaxf(fmaxf(v3[0], v3[1]), fmaxf(v3[2], v3[3]))); \
                    mrun[m] = fmaxf(mrun[m], fmaxf(t0, t1)); } } while (0)
    float bnd[2];
    {
        float km = 0.f;
        for (int t0 = 0; t0 < ntile; t0 += 4) {
            u32x4 ra[4], rb[4];
#pragma unroll
            for (int tt = 0; tt < 4; ++tt) { const bf16_t* src_ = Kb + (size_t)((t0 + tt) * 64 + skey) * 128 + sseg * 16; ra[tt] = *(const u32x4*)src_; rb[tt] = *(const u32x4*)(src_ + 8); }
            __builtin_amdgcn_sched_barrier(0);
#pragma unroll
            for (int tt = 0; tt < 4; ++tt) {
                const u32x4 a = ra[tt], b2 = rb[tt];
                float ss = 0.f;
                { const unsigned w[8] = {a.x, a.y, a.z, a.w, b2.x, b2.y, b2.z, b2.w};
#pragma unroll
                  for (int i = 0; i < 8; ++i) { const float lo = bf_lo(w[i]), hi = bf_hi(w[i]); ss += lo * lo + hi * hi; } }
                ss += dppf<0xB1>(ss); ss += dppf<0x4E>(ss);
                km = fmaxf(km, ss);
            }
        }
        km = fmaxf(km, shflx(km, 8, lane)); km = fmaxf(km, shflx(km, 16, lane)); km = fmaxf(km, shflx(km, 32, lane));
        volatile LAS float* red = (volatile LAS float*)(lds + 100000);
        __syncthreads();
        if ((lane & 59) == 0) red[wave * 2 + (lane >> 2)] = km;
        __syncthreads();
        float k2[2];
#pragma unroll
        for (int m = 0; m < 2; ++m) { float v = red[m]; for (int w = 1; w < 8; ++w) v = fmaxf(v, red[w * 2 + m]); k2[m] = v; }
        float bw = 0.f;
#pragma unroll
        for (int m = 0; m < 2; ++m) {
            float q2 = 0.f;
#pragma unroll
            for (int ks = 0; ks < 2; ++ks) { u32x4 u; __builtin_memcpy(&u, &qf[m][ks], 16); const unsigned w[4] = {u.x, u.y, u.z, u.w};
#pragma unroll
                for (int i = 0; i < 4; ++i) { const float lo = bf_lo(w[i]), hi = bf_hi(w[i]); q2 += lo * lo + hi * hi; } }
            q2 += shflx(q2, 16, lane); q2 += shflx(q2, 32, lane);
            bnd[m] = sqrtf(q2 * k2[m]) * 1.001f + 1e-3f; bw = fmaxf(bw, bnd[m]);
        }
        bw = fmaxf(bw, shflx(bw, 1, lane)); bw = fmaxf(bw, shflx(bw, 2, lane)); bw = fmaxf(bw, shflx(bw, 4, lane)); bw = fmaxf(bw, shflx(bw, 8, lane));
        __syncthreads();
        if (lane == 0) red[16 + wave] = bw;
        __syncthreads();
        float ball = red[16]; for (int w = 1; w < 8; ++w) ball = fmaxf(ball, red[16 + w]);
        bnd[0] = (ball > 60.f || (kp4()->probe & 256)) ? -1.f : bnd[0];
    }
    const bool exact = bnd[0] < 0.f;
    if (exact) {
        mrun[0] = mrun[1] = -INFINITY;
        u32x4 ka0, ka1;
        ATT_LDK(ka0, ka1, 0); ATT_WRK(ka0, ka1, 0);
        __syncthreads();
        for (int t = 0; t < ntile; ++t) {
            if (t + 1 < ntile) ATT_LDK(ka0, ka1, t + 1);
            ATT_P1(t & 1);
            if (t + 1 < ntile) ATT_WRK(ka0, ka1, (t + 1) & 1);
            __syncthreads();
        }
    }
    f32x4 negM[2];
#pragma unroll
    for (int m = 0; m < 2; ++m) { float mx = fmaxf(mrun[m], shflx(mrun[m], 16, lane)); mx = fmaxf(mx, shflx(mx, 32, lane)); if (!exact) mx = bnd[m]; negM[m] = (f32x4){-mx, -mx, -mx, -mx}; }
    f32x4 o0[8], o1[8]; float lsum[2] = {0.f, 0.f};
#pragma unroll
    for (int et = 0; et < 8; ++et) { o0[et] = zero4; o1[et] = zero4; }
#define ATT_SOFTMAX(pb0, pb1, sx) do { float e0_[8], e1_[8]; _Pragma("unroll") for (int sub = 0; sub < 2; ++sub) _Pragma("unroll") for (int j = 0; j < 4; ++j) { \
        e0_[sub * 4 + j] = __builtin_amdgcn_exp2f(sx[0][sub][j]); e1_[sub * 4 + j] = __builtin_amdgcn_exp2f(sx[1][sub][j]); } \
        lsum[0] += ((e0_[0] + e0_[1]) + (e0_[2] + e0_[3])) + ((e0_[4] + e0_[5]) + (e0_[6] + e0_[7])); lsum[1] += ((e1_[0] + e1_[1]) + (e1_[2] + e1_[3])) + ((e1_[4] + e1_[5]) + (e1_[6] + e1_[7])); \
        u32x4 pk_; pk_.x = pack_bf16_t(e0_[0], e0_[1]); pk_.y = pack_bf16_t(e0_[2], e0_[3]); pk_.z = pack_bf16_t(e0_[4], e0_[5]); pk_.w = pack_bf16_t(e0_[6], e0_[7]); __builtin_memcpy(&pb0, &pk_, 16); \
        pk_.x = pack_bf16_t(e1_[0], e1_[1]); pk_.y = pack_bf16_t(e1_[2], e1_[3]); pk_.z = pack_bf16_t(e1_[4], e1_[5]); pk_.w = pack_bf16_t(e1_[6], e1_[7]); __builtin_memcpy(&pb1, &pk_, 16); } while (0)
#define ATT_LDV(v0_, v1_, tt) do { const bf16_t* vs_ = Vb + (size_t)ve * L + (tt) * 64 + vseg * 16; v0_ = *(const u32x4*)vs_; v1_ = *(const u32x4*)(vs_ + 8); } while (0)
#define ATT_WRV(v0_, v1_, bi) do { *(LAS u32x4*)(Vt[bi] + vw0) = v0_; *(LAS u32x4*)(Vt[bi] + vw1) = v1_; } while (0)
#define ATT_P2(bi) do { const LAS unsigned char* kt_ = Kt[bi]; const LAS unsigned char* vt_ = Vt[bi]; \
            f32x4 sA[2][2], sB[2][2]; \
            { bf16x8 kfA[2][2][2], kfB[2][2][2]; ATT_RDK(kfA, kt_, 0); ATT_RDK(kfB, kt_, 1); __builtin_amdgcn_sched_barrier(0); \
              ATT_QK(sA, kfA, negM[0], negM[1]); ATT_QK(sB, kfB, negM[0], negM[1]); } __builtin_amdgcn_sched_barrier(0); \
            bf16x8 vfA[8], vfB[8], pA0, pA1, pB0, pB1; \
            _Pragma("unroll") for (int et = 0; et < 8; ++et) vfA[et] = *(const LAS bf16x8*)(vt_ + et * 2048 + vro0); \
            ATT_SOFTMAX(pA0, pA1, sA); __builtin_amdgcn_sched_barrier(0); \
            _Pragma("unroll") for (int et = 0; et < 8; ++et) vfB[et] = *(const LAS bf16x8*)(vt_ + et * 2048 + vro1); \
            _Pragma("unroll") for (int et = 0; et < 8; ++et) { o0[et] = __builtin_amdgcn_mfma_f32_16x16x32_bf16(vfA[et], pA0, o0[et], 0, 0, 0); o1[et] = __builtin_amdgcn_mfma_f32_16x16x32_bf16(vfA[et], pA1, o1[et], 0, 0, 0); } \
            ATT_SOFTMAX(pB0, pB1, sB); __builtin_amdgcn_sched_barrier(0); \
            _Pragma("unroll") for (int et = 0; et < 8; ++et) { o0[et] = __builtin_amdgcn_mfma_f32_16x16x32_bf16(vfB[et], pB0, o0[et], 0, 0, 0); o1[et] = __builtin_amdgcn_mfma_f32_16x16x32_bf16(vfB[et], pB1, o1[et], 0, 0, 0); } } while (0)
    {
        u32x4 ka0, ka1, va0, va1;
        ATT_LDK(ka0, ka1, 0); ATT_LDV(va0, va1, 0); ATT_WRK(ka0, ka1, 0); ATT_WRV(va0, va1, 0);
        __syncthreads();
        for (int t = 0; t < ntile; ++t) {
            if (t + 1 < ntile) { ATT_LDK(ka0, ka1, t + 1); ATT_LDV(va0, va1, t + 1); }
            ATT_P2(t & 1);
            if (t + 1 < ntile) { ATT_WRK(ka0, ka1, (t + 1) & 1); ATT_WRV(va0, va1, (t + 1) & 1); }
            __syncthreads();
        }
    }
#undef ATT_LDK
#undef ATT_WRK
#undef ATT_LDV
#undef ATT_WRV
#undef ATT_P1
#undef ATT_P2
#undef ATT_RDK
#undef ATT_QK
#undef ATT_SOFTMAX
    __builtin_amdgcn_s_setprio(0);
    float c0, c1;
    { float l0 = lsum[0]; l0 += shflx(l0, 16, lane); l0 += shflx(l0, 32, lane); float l1 = lsum[1]; l1 += shflx(l1, 16, lane); l1 += shflx(l1, 32, lane); c0 = 1.f / l0; c1 = lam / l1; }
    f32x4 o[8];
#pragma unroll
    for (int et = 0; et < 8; ++et) o[et] = o0[et] * c0 - o1[et] * c1;
    float ss = 0.f;
#pragma unroll
    for (int et = 0; et < 8; ++et) ss += o[et][0] * o[et][0] + o[et][1] * o[et][1] + o[et][2] * o[et][2] + o[et][3] * o[et][3];
    ss += shflx(ss, 16, lane); ss += shflx(ss, 32, lane);
    const float r = rsqrtf(ss * (1.f / 128.f) + 1e-6f) * (1.f - lam_init);
    const float* sg = kin(15) + layer * 128;
    f32x4 ggv[8];
#pragma unroll
    for (int et = 0; et < 8; ++et) ggv[et] = *(const f32x4*)(sg + et * 16 + 4 * g);
    __builtin_amdgcn_sched_barrier(0);
#pragma unroll
    for (int et = 0; et < 8; ++et) { const f32x4 gg = ggv[et]; const f32x4 v = o[et] * r * gg;
        u32x2 pk; pk.x = pack_bf16(v[0], v[1]); pk.y = pack_bf16(v[2], v[3]);
        *(u32x2*)(CAT + (size_t)qtok * 1280 + h * 128 + et * 16 + 4 * g) = pk; }
}

#define XB_TMO      128
#define XB_XCNT(j)  (256  + 64 * (j))
#define XB_XSUB(j)  (1280 + 64 * (j))
#define XB_XGEN(j)  (2304 + 64 * (j))
#define XB_TOP      3328
#define XB_TOPGEN   3392
#define XB_SPIN_CAP (1u << 18)
__device__ __forceinline__ unsigned xb_ld(unsigned* p)              { return __hip_atomic_load(p, __ATOMIC_RELAXED, __HIP_MEMORY_SCOPE_AGENT); }
__device__ __forceinline__ unsigned xb_add(unsigned* p, unsigned v) { return __hip_atomic_fetch_add(p, v, __ATOMIC_RELAXED, __HIP_MEMORY_SCOPE_AGENT); }
__device__ __forceinline__ unsigned xb_xcc_id() { return (unsigned)__builtin_amdgcn_s_getreg((3 << 11) | 20) & 0xFu; }
#define XB_SPIN(cond, bar) do { unsigned _sp = 0; while (cond) { __builtin_amdgcn_s_sleep(1); \
    if ((++_sp & 255u) == 0u) { if (xb_ld(&(bar)[XB_TMO])) break; if (_sp > XB_SPIN_CAP) { atomicAdd(&(bar)[XB_TMO], 1u); break; } } } } while (0)
__device__ __forceinline__ void xcd_barrier_complete(unsigned* bar, unsigned x, unsigned& nloc, unsigned& nx) {
    const unsigned G = gridDim.x;
    unsigned sum, cnt, mine, sp = 0u;
    for (;;) {
        sum = 0u; cnt = 0u; mine = 0u;
#pragma unroll
        for (unsigned j = 0; j < 16; ++j) { const unsigned c = xb_ld(&bar[XB_XCNT(j)]); sum += c; cnt += (c > 0u) ? 1u : 0u; mine = (j == x) ? c : mine; }
        if (sum == G) break;
        __builtin_amdgcn_s_sleep(1);
        if ((++sp & 255u) == 0u) { if (xb_ld(&bar[XB_TMO])) break; if (sp > XB_SPIN_CAP) { atomicAdd(&bar[XB_TMO], 1u); break; } }
    }
    nloc = mine > 0u ? mine : 1u; nx = cnt > 0u ? cnt : 1u;
}
__device__ __forceinline__ void xcd_barrier(unsigned* bar, volatile LAS unsigned* st) {
    asm volatile("s_waitcnt vmcnt(0)" ::: "memory");
    __syncthreads();
    if (tid_now() == 0) {
        const unsigned x = xb_xcc_id();
        __builtin_amdgcn_s_waitcnt(0);
        unsigned nloc = st[0], nx = st[1];
        if (nloc == 0u) { xcd_barrier_complete(bar, x, nloc, nx); st[0] = nloc; st[1] = nx; }
        const unsigned old = xb_add(&bar[XB_XSUB(x)], 1u);
        const unsigned gen = old / nloc;
        if (old + 1u == (gen + 1u) * nloc) {
            __builtin_amdgcn_fence(__ATOMIC_RELEASE, "agent");
            asm volatile("s_waitcnt vmcnt(0)" ::: "memory");
            const unsigned og = xb_add(&bar[XB_TOP], 1u);
            const unsigned tg = og / nx;
            if (og + 1u == (tg + 1u) * nx) xb_add(&bar[XB_TOPGEN], 1u);
            else XB_SPIN(xb_ld(&bar[XB_TOPGEN]) == tg, bar);
            __builtin_amdgcn_fence(__ATOMIC_ACQUIRE, "agent");
            xb_add(&bar[XB_XGEN(x)], 1u);
            asm volatile("s_waitcnt vmcnt(0)" ::: "memory");
        } else {
            XB_SPIN(xb_ld(&bar[XB_XGEN(x)]) == gen, bar);
            __builtin_amdgcn_fence(__ATOMIC_ACQUIRE, "agent");
            asm volatile("s_waitcnt vmcnt(0)" ::: "memory");
        }
    }
    __syncthreads();
}

__global__ void __launch_bounds__(512, 2) fwd_megakernel(Params p) {
    extern __shared__ __attribute__((aligned(16))) unsigned char shm[];
    LAS unsigned char* lds3 = (LAS unsigned char*)shm;
    const int ph_lo = kp4()->ph_lo, ph_hi = kp4()->ph_hi;
    {
        volatile LAS unsigned* st = (volatile LAS unsigned*)(lds3 + 131072 + 64);
        if (tid_now() == 0) { st[0] = 0u; st[1] = 0u; }
        __syncthreads();
    }
    int rep = 0;
    for (int ph = ph_lo; ph < ph_hi;) {
        unsigned char* ws = kws();
        bool again = false;
        { const int pmk = kp4()->probe; const int kk = ph < 2 ? -1 : (ph - 2) % 10;
            if (rep == 0 && (((pmk & 1) && ph == 0) || ((pmk & 2) && (kk == 3 || kk == 5)) || ((pmk & 4) && kk == 4) || ((pmk & 8) && (kk == 0 || kk == 7)) || ((pmk & 16) && (kk == 1 || kk == 8)) || ((pmk & 32) && ph == 1))) again = true; }
        int G = gridDim.x, c = blockIdx.x; asm volatile("" : "+s"(G), "+s"(c));
        if (ph <= 1) {
            if (ph == 0 && c == 0 && rep == 0) { unsigned* ctl = (unsigned*)(ws + OFF_CTL); for (int i = tid_now(); i < (int)(CTL_BYTES / 4); i += 512) ctl[i] = 0u; }
#ifndef DIS_ROW
            if (ph == 1) row_phase(-1, 0, 0.f, 0, 0);
#endif
#ifndef DIS_PREP
            {
                const int st0 = ph == 0 ? 0 : 5, st1 = ph == 0 ? (G != 256 ? 6 : 1) : (G != 256 ? 5 : 6);
                for (int st = st0; st < st1; ++st) prep_phase((LAS float*)lds3, st, c, G);
            }
#endif
        }
        else {
            const int l = (ph - 2) / 10, k = (ph - 2) % 10;
            if (k == 0 || k == 7) {
                const int s = k == 0 ? 0 : 1;
                pg8::StaticOrder S; S.init(NTOK, 2 * DFF, G, c);
                EpiSwiglu E; E.dummy = 0;
#ifndef DIS_G1
                pg8::gemm_phase(lds3, pg8::Gemm{(const bf16_t*)(ws + OFF_H), (const bf16_t*)(ws + OFF_WGU + (size_t)(l * 2 + s) * SZ_WGU), NTOK, 2 * DFF, 1024}, S, E);
#endif
                if (rep == 0 && c >= 128 && G == 256 && (l == 0 || k == 0)) prep_phase((LAS float*)lds3, l == 1 ? 4 : (k == 0 ? 1 : 2), c - 128, 128);
            } else if (k == 1 || k == 8 || k == 5) {
                pg8::Gemm gm;
                if (k == 5) gm = pg8::Gemm{(const bf16_t*)(ws + OFF_CAT), (const bf16_t*)(ws + OFF_WOUT + (size_t)l * SZ_WOUT), NTOK, 1024, 1280};
                else gm = pg8::Gemm{(const bf16_t*)(ws + OFF_ACT), (const bf16_t*)(ws + OFF_WDN + (size_t)(l * 2 + (k == 1 ? 0 : 1)) * SZ_WDN), NTOK, 1024, DFF};
                pg8::StaticOrder S; S.init(NTOK, 1024, G, c);
                EpiY E; E.ldc = 1024;
#ifndef DIS_GY
                pg8::gemm_phase(lds3, gm, S, E);
#endif
            } else if (k == 2) { row_phase(l, 0, 0.5f, l, 1); cache_convert(l, lds3); }
            else if (k == 3) {
                pg8::StaticOrder S; S.init(NTOK, NIN, G, c);
                EpiIn E; E.layer = l;
#ifndef DIS_GIN
                pg8::gemm_phase(lds3, pg8::Gemm{(const bf16_t*)(ws + OFF_H), (const bf16_t*)(ws + OFF_WIN + (size_t)l * SZ_WIN), NTOK, NIN, 1024}, S, E);
#endif
                if (l == 0 && rep == 0 && c >= 192 && G == 256) prep_phase((LAS float*)lds3, 3, c - 192, 64);
            } else if (k == 4) {
                const int pmx = kp4()->probe;
                if (c < 128 && !(rep == 1 && (pmx & 64))) {
                    const bool lt = c < 64; const int cc = c & 63, part = cc >> 5, uu = cc & 31;
                    pg8::OneUnit S; S.valid = 1; S.pm = lt ? (uu & 7) : 0; S.pn = lt ? (uu >> 3) : uu;
                    EpiDft E; E.tokbase = lt ? NCTX : 0; E.seqlen = lt ? 2048 : 256; E.coloff = 768 + part * 256;
                    pg8::Gemm gm = lt ? pg8::Gemm{(const bf16_t*)(ws + OFF_DLAT) + (size_t)part * 2048 * 2048, (const bf16_t*)(ws + OFF_FTL) + (size_t)part * 1024 * 2048, 2048, 1024, 2048}
                                      : pg8::Gemm{(const bf16_t*)(ws + OFF_DCTX) + (size_t)part * 256 * 256, (const bf16_t*)(ws + OFF_FTC) + (size_t)part * 8192 * 256, 256, 8192, 256};
#ifndef DIS_DFT
                    pg8::gemm_phase(lds3, gm, S, E);
#endif
                }
                volatile LAS int* sitem = (volatile LAS int*)(lds3 + 131072);
                const int myx = (int)(xb_xcc_id() & 7u);
                for (int xo = 0; xo < 8; ++xo) {
                    const int xq = (myx + xo) & 7;
                    unsigned* ctr = (unsigned*)(ws + OFF_CTL) + 4096 + 64 * ((rep * 2 + l) * 8 + xq);
                    for (;;) {
                        __syncthreads();
                        if (tid_now() == 0) *sitem = (int)atomicAdd(ctr, 1u);
                        __syncthreads();
                        const int i = *sitem;
                        if (i >= 64 || (rep == 1 && (pmx & 128))) break;
                        const int item = i < 32 ? 32 * xq + i : 256 + 32 * xq + (i - 32);
#ifndef DIS_ATT
                        attn_item(item, l, lds3);
#endif
                    }
                }
            } else if (k == 6) row_phase(l, 1, 1.0f, l, 2);
            else if (k == 9) row_phase(l, 2, 0.5f, l + 1 < 2 ? l + 1 : -1, 0);
        }
        if (again || ph + 1 < ph_hi) {
            if (ph == 0 && rep == 0) { cg::this_grid().sync();
                if (tid_now() == 0) (void)xb_add(&((unsigned*)(kws() + OFF_CTL))[XB_XCNT(xb_xcc_id())], 1u); }
            else xcd_barrier((unsigned*)(kws() + OFF_CTL), (volatile LAS unsigned*)(lds3 + 131072 + 64));
        }
        if (again) rep = 1; else { rep = 0; ++ph; }
    }
}

extern "C" void kernel_launch(void* const* d_in, const int* in_sizes, int n_in, void* d_out, int out_size, void* d_ws, size_t ws_size, hipStream_t stream) {
    static int grid = 0;
    if (grid == 0) {
        if (ws_size < WS_END) { fprintf(stderr, "kernel_launch: workspace too small: %zu < %zu\n", ws_size, (size_t)WS_END); grid = -1; return; }
        if (hipFuncSetAttribute((const void*)fwd_megakernel, hipFuncAttributeMaxDynamicSharedMemorySize, LDS_BYTES) != hipSuccess) { fprintf(stderr, "kernel_launch: hipFuncSetAttribute failed\n"); grid = -1; return; }
        int dev = 0, cus = 0, per_cu = 0;
        hipGetDevice(&dev); hipDeviceGetAttribute(&cus, hipDeviceAttributeMultiprocessorCount, dev);
        hipOccupancyMaxActiveBlocksPerMultiprocessor(&per_cu, (const void*)fwd_megakernel, 512, LDS_BYTES);
        if (per_cu < 1) { fprintf(stderr, "kernel_launch: occupancy query says %d blocks per CU\n", per_cu); per_cu = 1; }
        (void)hipGetLastError();
        grid = cus;
    }
    if (grid < 0) return;
    Params p{};
    for (int i = 0; i < 16; ++i) p.in[i] = (const float*)d_in[i];
    p.out = (float*)d_out; p.ws = (unsigned char*)d_ws; p.probe = PROBE_MASK;
#if MK_PER_PHASE
    for (int ph = 0; ph < NPHASE; ++ph) { p.ph_lo = ph; p.ph_hi = ph + 1; hipLaunchKernelGGL(fwd_megakernel, dim3(grid), dim3(512), LDS_BYTES, stream, p); }
#else
    p.ph_lo = 0; p.ph_hi = NPHASE;
    void* args[] = {&p};
    hipError_t e = hipLaunchCooperativeKernel((const void*)fwd_megakernel, dim3(grid), dim3(512), args, LDS_BYTES, stream);
    if (e != hipSuccess) fprintf(stderr, "cooperative launch failed: %s (grid %d)\n", hipGetErrorString(e), grid);
#endif
}
```

```cpp
#include <hip/hip_runtime.h>
#include <hip/hip_cooperative_groups.h>
#include <cstdio>
namespace cg = cooperative_groups;

#ifndef MK_PER_PHASE
#define MK_PER_PHASE 0
#endif

#ifndef PROBE_MASK
#define PROBE_MASK 0
#endif
#define LAS __attribute__((address_space(3)))
typedef unsigned short bf16_t;
typedef short bf16x8 __attribute__((ext_vector_type(8)));
typedef short bf16x4 __attribute__((ext_vector_type(4)));
typedef float f32x4 __attribute__((ext_vector_type(4)));
typedef unsigned u32x2 __attribute__((ext_vector_type(2)));
typedef unsigned u32x4 __attribute__((ext_vector_type(4)));

constexpr int DM = 1024, NTOK = 16384, NCTX = 8192, DFF = 2816, NIN = 2816;
constexpr int LDS_BYTES = 131072 + 1024;
constexpr int NPHASE = 22;

constexpr size_t SZ_WGU = (size_t)5632 * 1024 * 2, SZ_WDN = (size_t)1024 * 2816 * 2, SZ_WIN = (size_t)2816 * 1024 * 2, SZ_WOUT = (size_t)1024 * 1280 * 2;
constexpr size_t OFF_WGU = 0;
constexpr size_t OFF_WDN = OFF_WGU + 4 * SZ_WGU;
constexpr size_t OFF_WIN = OFF_WDN + 4 * SZ_WDN;
constexpr size_t OFF_WOUT = OFF_WIN + 2 * SZ_WIN;
constexpr size_t OFF_DLAT = OFF_WOUT + 2 * SZ_WOUT;
constexpr size_t OFF_DCTX = OFF_DLAT + (size_t)2048 * 4096 * 2;
constexpr size_t OFF_MOD = OFF_DCTX + (size_t)256 * 512 * 2;
constexpr size_t OFF_ROPE = OFF_MOD + (size_t)2 * 5 * 9216 * 4;
constexpr size_t OFF_MISC = OFF_ROPE + 8192;
constexpr size_t OFF_CTL = OFF_MISC + 1024;
constexpr size_t CTL_BYTES = 32768;
constexpr size_t OFF_H = OFF_CTL + CTL_BYTES;
constexpr size_t OFF_Y = OFF_H;
constexpr size_t OFF_XB = OFF_H + (size_t)NTOK * 1024 * 2;
constexpr size_t OFF_U = OFF_XB + (size_t)NTOK * 1024 * 2;
constexpr size_t OFF_ACT = OFF_U;
constexpr size_t OFF_Q = OFF_U;
constexpr size_t OFF_KC = OFF_Q + (size_t)NTOK * 512 * 2;
constexpr size_t OFF_VTC = OFF_KC + (size_t)32 * 4 * 256 * 128 * 2;
constexpr size_t OFF_KL = OFF_VTC + (size_t)32 * 4 * 128 * 256 * 2;
constexpr size_t OFF_VTL = OFF_KL + (size_t)4 * 4 * 2560 * 128 * 2;
constexpr size_t OFF_CONV = OFF_VTL + (size_t)4 * 4 * 128 * 2560 * 2;
constexpr size_t OFF_FTL = OFF_CONV + (size_t)3 * NTOK * 256 * 2;
constexpr size_t OFF_FTC = OFF_FTL + (size_t)1024 * 4096 * 2;
constexpr size_t END_MIX = OFF_FTC + (size_t)8192 * 512 * 2;
constexpr size_t END_ACT = OFF_ACT + (size_t)NTOK * DFF * 2;
constexpr size_t OFF_CAT = END_MIX;
constexpr size_t END_CAT = OFF_CAT + (size_t)NTOK * 1280 * 2;
constexpr size_t WS_END = END_CAT > END_ACT ? END_CAT : END_ACT;

struct Params {
    const float* in[16];
    float* out;
    unsigned char* ws;
    int ph_lo, ph_hi, probe, pad;
};

#define AS1 __attribute__((address_space(1)))
#define AS4 __attribute__((address_space(4)))
template <class T> __device__ __forceinline__ T* as_global(T* p) { return (T*)(AS1 T*)p; }
#if defined(__HIP_DEVICE_COMPILE__)
__device__ __forceinline__ const AS4 Params* kp4() { const AS4 Params* kp = (const AS4 Params*)__builtin_amdgcn_kernarg_segment_ptr(); asm volatile("" : "+s"(kp)); return kp; }
#else
__device__ const AS4 Params* kp4();
#endif
__device__ __forceinline__ const float* kin(int i) { return as_global(kp4()->in[i]); }
__device__ __forceinline__ float* kout() { return as_global(kp4()->out); }
__device__ __forceinline__ unsigned char* kws() { return as_global(kp4()->ws); }
__device__ __forceinline__ int tid_now() { int t = threadIdx.x; asm volatile("" : "+v"(t)); return t; }
__device__ __forceinline__ int permk(int key) { return (key & ~31) | (((key >> 2) & 3) << 3) | (((key >> 4) & 1) << 2) | (key & 3); }
__device__ __forceinline__ unsigned pack_bf16_t(float lo, float hi) { unsigned r; asm("s_nop 0\n\tv_cvt_pk_bf16_f32 %0, %1, %2" : "=v"(r) : "v"(lo), "v"(hi)); return r; }
__device__ __forceinline__ unsigned pack_bf16(float lo, float hi) { unsigned r; asm("v_cvt_pk_bf16_f32 %0, %1, %2" : "=v"(r) : "v"(lo), "v"(hi)); return r; }
__device__ __forceinline__ float bf_lo(unsigned u) { return __uint_as_float(u << 16); }
__device__ __forceinline__ float bf_hi(unsigned u) { return __uint_as_float(u & 0xffff0000u); }
__device__ __forceinline__ float shflx(float v, int mask, int lane) { return __int_as_float(__builtin_amdgcn_ds_bpermute((lane ^ mask) << 2, __float_as_int(v))); }
template <int CTRL> __device__ __forceinline__ float dppf(float v) { return __int_as_float(__builtin_amdgcn_update_dpp(0, __float_as_int(v), CTRL, 0xF, 0xF, true)); }
__device__ __forceinline__ float wave_sum(float v, int lane) {
    v += dppf<0xB1>(v); v += dppf<0x4E>(v); v += dppf<0x141>(v); v += dppf<0x140>(v);
    const float s0 = __int_as_float(__builtin_amdgcn_readlane(__float_as_int(v), 0)), s1 = __int_as_float(__builtin_amdgcn_readlane(__float_as_int(v), 16));
    const float s2 = __int_as_float(__builtin_amdgcn_readlane(__float_as_int(v), 32)), s3 = __int_as_float(__builtin_amdgcn_readlane(__float_as_int(v), 48));
    (void)lane; return (s0 + s1) + (s2 + s3);
}

namespace pg8 {
constexpr int BM = 256, BK = 64, HALF = 128, HTB = HALF * BK * 2, STAGE_BYTES = 8 * HTB, NXCD = 8, WGM = 8;
__device__ __forceinline__ int lds_byte(int r, int c) { const int st = (r >> 4) * 2 + (c >> 5), rr = r & 15, cc = c & 31, ob = rr * 64 + cc * 2; return st * 1024 + (ob ^ (((ob >> 9) & 1) << 5)); }
__device__ __forceinline__ void stage_rc(int b, int& R, int& C) { const int st = b / 1024, sb = b % 1024, swz = sb ^ (((sb >> 9) & 1) << 5); R = (st >> 1) * 16 + swz / 64; C = (st & 1) * 32 + (swz % 64) / 2; }
struct Unit { int pm, pn; };
struct Gemm { const bf16_t* A; const bf16_t* Bt; int M, N, K; };
struct StaticOrder {
    int nM, nN, nwg, G, c;
    __device__ void init(int M, int N, int G_, int c_) { nM = M / BM; nN = N / BM; nwg = nM * nN; G = G_; c = c_; }
    __device__ bool next(int i, Unit& u) const {
        const long L = (long)i * G + c; if (L >= nwg) return false;
        int wgid = (int)L; { const int q = nwg / NXCD, r = nwg % NXCD, xcd = wgid % NXCD, off = wgid / NXCD; wgid = (xcd < r ? xcd * (q + 1) : r * (q + 1) + (xcd - r) * q) + off; }
        const int nig = WGM * nN, gid = wgid / nig, fm = gid * WGM, gsz = (nM - fm) < WGM ? (nM - fm) : WGM;
        u.pm = fm + ((wgid % nig) % gsz); u.pn = (wgid % nig) / gsz; return true;
    }
    __device__ __forceinline__ void a_ready(const Unit&) const {}
    __device__ __forceinline__ void done(const Unit&) const {}
};
struct OneUnit {
    int valid, pm, pn;
    __device__ bool next(int i, Unit& u) const { if (i != 0 || !valid) return false; u.pm = pm; u.pn = pn; return true; }
    __device__ __forceinline__ void a_ready(const Unit&) const {}
    __device__ __forceinline__ void done(const Unit&) const {}
};

template <class Epi, class Sched>
__device__ __forceinline__ void gemm_phase(LAS unsigned char* lds, const Gemm g, const Sched& S, const Epi& E) {
    const int tid = tid_now(), wid = __builtin_amdgcn_readfirstlane(tid >> 6), lane = tid & 63, wr = wid >> 2, wc = wid & 3, fr = lane & 15, fq = lane >> 4;
    const int K = g.K, nt = K / BK;
    unsigned voffA[2], voffB[2];
#pragma unroll
    for (int i = 0; i < 2; ++i) { int R, C; stage_rc(tid * 16 + i * 8192, R, C); voffA[i] = (unsigned)(R * K + C) * 2u; voffB[i] = voffA[i]; }
    const size_t kstep = (size_t)(BK * 2);
    const size_t hstep = (size_t)HALF * K * 2;
    const size_t tstep = 2 * hstep;
    const unsigned ldsw = (unsigned)wid * 1024u;
    const int aoff = lds_byte(wr * 64 + fr, fq * 8), boff = lds_byte(wc * 32 + fr, fq * 8);
#define PG8_SA(b, h) (((b) * 2 + (h)) * HTB)
#define PG8_SB(b, h) ((4 + (b) * 2 + (h)) * HTB)
#define PG8_STAGE(bufoff, gbase, voff) do { _Pragma("unroll") for (int _i = 0; _i < 2; ++_i) \
        __builtin_amdgcn_global_load_lds((const unsigned*)((const char*)(gbase) + (voff)[_i]), (LAS unsigned*)(lds + (bufoff) + ldsw + _i * 8192), 16, 0, 0); } while (0)
#define PG8_LDA(dst, b, h) do { _Pragma("unroll") for (int m = 0; m < 4; ++m) _Pragma("unroll") for (int k = 0; k < 2; ++k) dst[m][k] = *(const LAS bf16x8*)(lds + PG8_SA(b, h) + aoff + m * 2048 + k * 1024); } while (0)
#define PG8_LDB(dst, b, h) do { _Pragma("unroll") for (int n = 0; n < 2; ++n) _Pragma("unroll") for (int k = 0; k < 2; ++k) dst[n][k] = *(const LAS bf16x8*)(lds + PG8_SB(b, h) + boff + n * 2048 + k * 1024); } while (0)
#define PG8_MMA(ai, bj, At, Bt) do { __builtin_amdgcn_s_setprio(1); _Pragma("unroll") for (int m = 0; m < 4; ++m) _Pragma("unroll") for (int n = 0; n < 2; ++n) _Pragma("unroll") for (int k = 0; k < 2; ++k) \
        acc[ai][bj][m][n] = __builtin_amdgcn_mfma_f32_16x16x32_bf16(Bt[n][k], At[m][k], acc[ai][bj][m][n], 0, 0, 0); __builtin_amdgcn_s_setprio(0); } while (0)
#define PG8_WAIT_V(n) asm volatile("s_waitcnt vmcnt(" #n ")" ::: "memory")
#define PG8_WAIT_L(n) asm volatile("s_waitcnt lgkmcnt(" #n ")" ::: "memory")
#define PG8_BAR __builtin_amdgcn_s_barrier()
#define PG8_SCHED __builtin_amdgcn_sched_barrier(0)
    Unit cur, nxt; int ui = 0;
    if (!S.next(0, cur)) return;
    f32x4 acc[2][2][4][2];
#pragma unroll
    for (int a = 0; a < 2; ++a)
#pragma unroll
        for (int b = 0; b < 2; ++b)
#pragma unroll
            for (int m = 0; m < 4; ++m)
#pragma unroll
                for (int n = 0; n < 2; ++n) acc[a][b][m][n] = (f32x4){0.f, 0.f, 0.f, 0.f};
    bf16x8 At[4][2], B0[2][2], B1[2][2];
    const char* cA = (const char*)g.A + (size_t)cur.pm * tstep; const char* cB = (const char*)g.Bt + (size_t)cur.pn * tstep;
    S.a_ready(cur);
    PG8_STAGE(PG8_SB(0, 0), cB, voffB); PG8_STAGE(PG8_SA(0, 0), cA, voffA); PG8_STAGE(PG8_SB(0, 1), cB + hstep, voffB); PG8_STAGE(PG8_SA(0, 1), cA + hstep, voffA);
    if (wr == 1) PG8_BAR;
    PG8_WAIT_V(4); PG8_BAR;
    PG8_STAGE(PG8_SB(1, 0), cB + kstep, voffB); PG8_STAGE(PG8_SA(1, 0), cA + kstep, voffA); PG8_STAGE(PG8_SB(1, 1), cB + hstep + kstep, voffB);
    PG8_WAIT_V(6); PG8_BAR;
    for (;;) {
        const bool has_next = S.next(ui + 1, nxt);
        const char* nA = has_next ? (const char*)g.A + (size_t)nxt.pm * tstep : cA; const char* nB = has_next ? (const char*)g.Bt + (size_t)nxt.pn * tstep : cB;
        for (int t = 0; t < nt; t += 2) {
            const bool last = (t == nt - 2);
            const char* a1 = cA + (size_t)(t + 1) * kstep;
            const char* a2 = last ? nA : cA + (size_t)(t + 2) * kstep; const char* b2 = last ? nB : cB + (size_t)(t + 2) * kstep;
            const char* a3 = a2 + kstep; const char* b3 = b2 + kstep;
            if (last && has_next) S.a_ready(nxt);
            PG8_LDB(B0, 0, 0); PG8_SCHED; PG8_LDA(At, 0, 0); PG8_STAGE(PG8_SA(1, 1), a1 + hstep, voffA);
            PG8_WAIT_L(8); PG8_BAR; PG8_WAIT_L(0); PG8_MMA(0, 0, At, B0); PG8_BAR; PG8_SCHED;
            PG8_LDB(B1, 0, 1); PG8_STAGE(PG8_SB(0, 0), b2, voffB);
            PG8_BAR; PG8_WAIT_L(0); PG8_MMA(0, 1, At, B1); PG8_BAR;
            PG8_LDA(At, 0, 1); PG8_STAGE(PG8_SA(0, 0), a2, voffA);
            PG8_BAR; PG8_WAIT_L(0); PG8_MMA(1, 0, At, B0); PG8_BAR; PG8_SCHED;
            PG8_STAGE(PG8_SB(0, 1), b2 + hstep, voffB);
            PG8_WAIT_V(6); PG8_BAR; PG8_MMA(1, 1, At, B1); PG8_BAR;
            PG8_LDB(B0, 1, 0); PG8_SCHED; PG8_LDA(At, 1, 0); PG8_STAGE(PG8_SA(0, 1), a2 + hstep, voffA);
            PG8_WAIT_L(8); PG8_BAR; PG8_WAIT_L(0); PG8_MMA(0, 0, At, B0); PG8_BAR; PG8_SCHED;
            PG8_LDB(B1, 1, 1); PG8_STAGE(PG8_SB(1, 0), b3, voffB);
            PG8_BAR; PG8_WAIT_L(0); PG8_MMA(0, 1, At, B1); PG8_BAR;
            PG8_LDA(At, 1, 1); PG8_STAGE(PG8_SA(1, 0), a3, voffA);
            PG8_BAR; PG8_WAIT_L(0); PG8_MMA(1, 0, At, B0); PG8_BAR; PG8_SCHED;
            PG8_STAGE(PG8_SB(1, 1), b3 + hstep, voffB);
            PG8_WAIT_V(6); PG8_BAR; PG8_MMA(1, 1, At, B1); PG8_BAR;
        }
        { const int tl = tid_now(); const int ew = __builtin_amdgcn_readfirstlane(tl >> 6), el = tl & 63;
          E(acc, cur, ew >> 2, ew & 3, el & 15, el >> 4); } S.done(cur);
        if (!has_next) break;
#pragma unroll
        for (int a = 0; a < 2; ++a)
#pragma unroll
            for (int b = 0; b < 2; ++b)
#pragma unroll
                for (int m = 0; m < 4; ++m)
#pragma unroll
                    for (int n = 0; n < 2; ++n) acc[a][b][m][n] = (f32x4){0.f, 0.f, 0.f, 0.f};
        cur = nxt; cA = nA; cB = nB; ++ui;
    }
    PG8_WAIT_V(0);
    if (wr == 0) PG8_BAR;
    PG8_BAR;
#undef PG8_SA
#undef PG8_SB
#undef PG8_STAGE
#undef PG8_LDA
#undef PG8_LDB
#undef PG8_MMA
#undef PG8_WAIT_V
#undef PG8_WAIT_L
#undef PG8_BAR
#undef PG8_SCHED
}
}
using pg8::Unit;


struct EpiSwiglu {
    int dummy;
    __device__ __forceinline__ void operator()(const f32x4 (&acc)[2][2][4][2], const Unit& u, int wr, int wc, int fr, int fq) const {
        bf16_t* O = (bf16_t*)(kws() + OFF_ACT);
        const int row0 = u.pm * 256 + wr * 64 + fr, hid = 128 * u.pn + 32 * wc + 8 * fq;
#pragma unroll
        for (int ai = 0; ai < 2; ++ai)
#pragma unroll
            for (int m = 0; m < 4; ++m) {
                u32x4 pk;
#pragma unroll
                for (int bj = 0; bj < 2; ++bj) {
                    const f32x4 g = acc[ai][bj][m][0], uu = acc[ai][bj][m][1];
                    float o[4];
#pragma unroll
                    for (int j = 0; j < 4; ++j) o[j] = g[j] * __builtin_amdgcn_rcpf(1.f + __expf(-g[j])) * uu[j];
                    if (bj == 0) { pk.x = pack_bf16(o[0], o[1]); pk.y = pack_bf16(o[2], o[3]); } else { pk.z = pack_bf16(o[0], o[1]); pk.w = pack_bf16(o[2], o[3]); }
                }
                *(u32x4*)(O + (size_t)(row0 + ai * 128 + m * 16) * DFF + hid) = pk;
            }
    }
};
struct EpiY {
    int ldc;
    __device__ __forceinline__ void operator()(const f32x4 (&acc)[2][2][4][2], const Unit& u, int wr, int wc, int fr, int fq) const {
        bf16_t* O = (bf16_t*)(kws() + OFF_Y);
        const int row0 = u.pm * 256 + wr * 64 + fr, col0 = u.pn * 256 + wc * 32 + 8 * fq;
#pragma unroll
        for (int ai = 0; ai < 2; ++ai)
#pragma unroll
            for (int m = 0; m < 4; ++m) {
                bf16_t* rowp = O + (size_t)(row0 + ai * 128 + m * 16) * ldc + col0;
#pragma unroll
                for (int bj = 0; bj < 2; ++bj) {
                    const f32x4 v0 = acc[ai][bj][m][0], v1 = acc[ai][bj][m][1];
                    u32x4 pk; pk.x = pack_bf16(v0[0], v0[1]); pk.y = pack_bf16(v0[2], v0[3]); pk.z = pack_bf16(v1[0], v1[1]); pk.w = pack_bf16(v1[2], v1[3]);
                    *(u32x4*)(rowp + bj * 128) = pk;
                }
            }
    }
};
struct EpiDft {
    int tokbase, seqlen, coloff;
    __device__ __forceinline__ void operator()(const f32x4 (&acc)[2][2][4][2], const Unit& u, int wr, int wc, int fr, int fq) const {
        bf16_t* CAT = (bf16_t*)(kws() + OFF_CAT);
        const int row0 = u.pm * 256 + wr * 64 + fr; const int b = u.pn;
        const int col0 = wc * 32 + 4 * fq;
#pragma unroll
        for (int ai = 0; ai < 2; ++ai)
#pragma unroll
            for (int m = 0; m < 4; ++m) {
                bf16_t* rowp = CAT + (size_t)(tokbase + b * seqlen + row0 + ai * 128 + m * 16) * 1280 + coloff + col0;
#pragma unroll
                for (int bj = 0; bj < 2; ++bj)
#pragma unroll
                    for (int n = 0; n < 2; ++n) {
                        const f32x4 v = acc[ai][bj][m][n];
                        u32x2 pk; pk.x = pack_bf16(v[0], v[1]); pk.y = pack_bf16(v[2], v[3]);
                        *(u32x2*)(rowp + bj * 128 + n * 16) = pk;
                    }
            }
    }
};
struct EpiIn {
    int layer;
    __device__ __forceinline__ void operator()(const f32x4 (&acc)[2][2][4][2], const Unit& u, int wr, int wc, int fr, int fq) const {
        unsigned char* ws = kws(); float* outk = kout() + (size_t)2 * NCTX * 1024; float* outv = outk + (size_t)NCTX * 1024;
        const float* ropec = (const float*)(ws + OFF_ROPE); const float* ropes = ropec + 1024;
        const int pn = u.pn; const bool lat = u.pm >= 32;
        const int row0 = u.pm * 256 + wr * 64 + fr;
        if (pn < 4) {
            const bool isq = pn < 2; const int axis = wc & 1; const int mm = wc >> 1;
            const float qs = isq ? 0.125f * 1.44269504089f : 1.0f;
#pragma unroll
            for (int ai = 0; ai < 2; ++ai)
#pragma unroll
                for (int m = 0; m < 4; ++m) { __builtin_amdgcn_sched_barrier(0);
                    const int r = row0 + ai * 128 + m * 16;
                    f32x4 cs = (f32x4){1.f, 1.f, 1.f, 1.f}, sn = (f32x4){0.f, 0.f, 0.f, 0.f};
                    int b, s;
                    if (lat) { const int t = (r - NCTX) & 2047; b = (r - NCTX) >> 11; s = t; const int pos = axis ? (t & 63) : (t >> 6);
                        cs = *(const f32x4*)(ropec + pos * 16 + 4 * fq); sn = *(const f32x4*)(ropes + pos * 16 + 4 * fq); }
                    else { b = r >> 8; s = r & 255; }
#pragma unroll
                    for (int bj = 0; bj < 2; ++bj) {
                        const int h = 2 * (pn & 1) + bj;
                        const f32x4 x1 = acc[ai][bj][m][0], x2 = acc[ai][bj][m][1];
                        f32x4 y1, y2;
#pragma unroll
                        for (int j = 0; j < 4; ++j) { y1[j] = (x1[j] * cs[j] - x2[j] * sn[j]) * qs; y2[j] = (x2[j] * cs[j] + x1[j] * sn[j]) * qs; }
                        const int cc = mm * 64 + axis * 32 + 4 * fq;
                        u32x2 p1, p2; p1.x = pack_bf16(y1[0], y1[1]); p1.y = pack_bf16(y1[2], y1[3]); p2.x = pack_bf16(y2[0], y2[1]); p2.y = pack_bf16(y2[2], y2[3]);
                        if (isq) {
                            bf16_t* qp = (bf16_t*)(ws + OFF_Q) + (size_t)r * 512 + h * 128 + cc;
                            *(u32x2*)qp = p1; *(u32x2*)(qp + 16) = p2;
                        } else {
                            bf16_t* kp = lat ? (bf16_t*)(ws + OFF_KL) + ((size_t)(b * 4 + h) * 2560 + s) * 128 + cc
                                             : (bf16_t*)(ws + OFF_KC) + ((size_t)(b * 4 + h) * 256 + s) * 128 + cc;
                            *(u32x2*)kp = p1; *(u32x2*)(kp + 16) = p2;
                            if (!lat) { float* ok = outk + ((size_t)(b * 2 + layer) * 256 + s) * 512 + h * 128 + cc; *(f32x4*)ok = x1; *(f32x4*)(ok + 16) = x2; }
                        }
                    }
                }
        } else if (pn < 6) {
#pragma unroll
            for (int ai = 0; ai < 2; ++ai)
#pragma unroll
                for (int m = 0; m < 4; ++m) { __builtin_amdgcn_sched_barrier(0);
                    const int r = row0 + ai * 128 + m * 16;
                    int b, s; if (lat) { b = (r - NCTX) >> 11; s = (r - NCTX) & 2047; } else { b = r >> 8; s = r & 255; }
#pragma unroll
                    for (int bj = 0; bj < 2; ++bj) {
                        const int h = 2 * (pn & 1) + bj;
#pragma unroll
                        for (int n = 0; n < 2; ++n) {
                            const f32x4 v = acc[ai][bj][m][n]; const int e = wc * 32 + n * 16 + 4 * fq;
                            bf16_t* vp = lat ? (bf16_t*)(ws + OFF_VTL) + ((size_t)(b * 4 + h) * 128 + e) * 2560 + permk(s)
                                             : (bf16_t*)(ws + OFF_VTC) + ((size_t)(b * 4 + h) * 128 + e) * 256 + permk(s);
                            const int ldv = lat ? 2560 : 256;
                            const unsigned p01 = pack_bf16(v[0], v[1]), p23 = pack_bf16(v[2], v[3]);
                            {
                                const int odd = fr & 1; const unsigned mine = odd ? p23 : p01, send = odd ? p01 : p23;
                                const unsigned recv = (unsigned)__builtin_amdgcn_update_dpp(0, (int)send, 0xB1, 0xF, 0xF, true);
                                const unsigned w0 = odd ? ((recv & 0xffffu) | (mine << 16)) : ((mine & 0xffffu) | (recv << 16));
                                const unsigned w1 = odd ? ((recv >> 16) | (mine & 0xffff0000u)) : ((mine >> 16) | (recv & 0xffff0000u));
                                bf16_t* vq = vp + (odd ? 2 * ldv - 1 : 0);
                                *(unsigned*)vq = w0; *(unsigned*)(vq + ldv) = w1; }
                            if (!lat) *(f32x4*)(outv + ((size_t)(b * 2 + layer) * 256 + s) * 512 + h * 128 + e) = v;
                        }
                    }
                }
        } else if (pn < 9) {
            bf16_t* base = (bf16_t*)(ws + OFF_CONV) + (size_t)(pn - 6) * NTOK * 256;
#pragma unroll
            for (int ai = 0; ai < 2; ++ai)
#pragma unroll
                for (int m = 0; m < 4; ++m) { __builtin_amdgcn_sched_barrier(0);
                    bf16_t* rowp = base + (size_t)(row0 + ai * 128 + m * 16) * 256 + wc * 32 + 8 * fq;
#pragma unroll
                    for (int bj = 0; bj < 2; ++bj) {
                        const f32x4 v0 = acc[ai][bj][m][0], v1 = acc[ai][bj][m][1];
                        u32x4 pk; pk.x = pack_bf16(v0[0], v0[1]); pk.y = pack_bf16(v0[2], v0[3]); pk.z = pack_bf16(v1[0], v1[1]); pk.w = pack_bf16(v1[2], v1[3]);
                        *(u32x4*)(rowp + bj * 128) = pk;
                    }
                }
        } else {
            const int part = pn - 9;
#pragma unroll
            for (int ai = 0; ai < 2; ++ai)
#pragma unroll
                for (int m = 0; m < 4; ++m) { __builtin_amdgcn_sched_barrier(0);
                    const int r = row0 + ai * 128 + m * 16;
                    int b, s; if (lat) { b = (r - NCTX) >> 11; s = (r - NCTX) & 2047; } else { b = r >> 8; s = r & 255; }
#pragma unroll
                    for (int bj = 0; bj < 2; ++bj)
#pragma unroll
                        for (int n = 0; n < 2; ++n) {
                            const f32x4 v = acc[ai][bj][m][n]; const int c = bj * 128 + wc * 32 + n * 16 + 4 * fq;
                            const int ldf = lat ? 2048 : 256;
                            bf16_t* fp = lat ? (bf16_t*)(ws + OFF_FTL) + (size_t)part * 1024 * 2048 + (size_t)(b * 256 + c) * 2048 + s
                                             : (bf16_t*)(ws + OFF_FTC) + (size_t)part * 8192 * 256 + (size_t)(b * 256 + c) * 256 + s;
                            const unsigned p01 = pack_bf16(v[0], v[1]), p23 = pack_bf16(v[2], v[3]);
                            {
                                const int odd = fr & 1; const unsigned mine = odd ? p23 : p01, send = odd ? p01 : p23;
                                const unsigned recv = (unsigned)__builtin_amdgcn_update_dpp(0, (int)send, 0xB1, 0xF, 0xF, true);
                                const unsigned w0 = odd ? ((recv & 0xffffu) | (mine << 16)) : ((mine & 0xffffu) | (recv << 16));
                                const unsigned w1 = odd ? ((recv >> 16) | (mine & 0xffff0000u)) : ((mine >> 16) | (recv & 0xffff0000u));
                                bf16_t* fq2 = fp + (odd ? 2 * ldf - 1 : 0);
                                *(unsigned*)fq2 = w0; *(unsigned*)(fq2 + ldf) = w1; }
                        }
                }
        }
    }
};

__device__ __forceinline__ int srccol_gu(int np) { const int pn = np >> 8, bj = (np >> 7) & 1, wc = (np >> 5) & 3, n = (np >> 4) & 1, i = np & 15;
    const int hid = 128 * pn + 32 * wc + 8 * (i >> 2) + 4 * bj + (i & 3); return n ? 2816 + hid : hid; }

__device__ __forceinline__ void xpose_tile(LAS float* tile, const float* src, int ld, int k0, int np0, int mode, int kd0, bf16_t* dst, int K) {
    const int tid = tid_now();
    { const int j4 = (tid & 63) * 4, kb = tid >> 6; const int npj = np0 + j4; const int sc = mode == 1 ? srccol_gu(npj) : (mode == 2 ? (npj & ~31) + 8 * ((npj & 15) >> 2) + 4 * ((npj >> 4) & 1) + (npj & 3) : npj);
      f32x4 v[8];
#pragma unroll
      for (int i = 0; i < 8; ++i) v[i] = *(const f32x4*)(src + (size_t)(k0 + kb + 8 * i) * ld + sc);
#pragma unroll
      for (int i = 0; i < 8; ++i) { LAS float* t = tile + (kb + 8 * i) * 257 + j4; t[0] = v[i][0]; t[1] = v[i][1]; t[2] = v[i][2]; t[3] = v[i][3]; } }
    __syncthreads();
    { const int kg = (tid & 7) * 8, nb = tid >> 3;
#pragma unroll
      for (int i = 0; i < 4; ++i) { const int n = nb + 64 * i; const LAS float* t = tile + kg * 257 + n;
          u32x4 pk; pk.x = pack_bf16(t[0], t[257]); pk.y = pack_bf16(t[2 * 257], t[3 * 257]); pk.z = pack_bf16(t[4 * 257], t[5 * 257]); pk.w = pack_bf16(t[6 * 257], t[7 * 257]);
          *(u32x4*)(dst + (size_t)(np0 + n) * K + kd0 + kg) = pk; } }
    __syncthreads();
}

__device__ __forceinline__ void prep_phase(LAS float* lds, int stage, int rank, int nblk) {
    const int tid = tid_now();
    unsigned char* ws = kws();
    constexpr int J_WGU = 4 * 16 * 22, J_WDN = 4 * 44 * 4, J_WIN = 2 * 16 * 9, J_FCS = 2 * 16 * 8, J_WOUT = 2 * 20 * 4, J_MOD = 144, J_DL = 256, J_DC = 8, J_MISC = 1;
    constexpr int E1 = J_WGU, E2 = E1 + J_WDN, E3 = E2 + J_WIN, E4 = E3 + J_FCS, E5 = E4 + J_WOUT, E6 = E5 + J_MOD, E7 = E6 + J_DL, E8 = E7 + J_DC, E9 = E8 + J_MISC;
    int s0, n0, s1, n1, s2, n2, s3, n3, s4, n4, s5, n5;
    if (stage == 0)      { s0 = E5; n0 = 72; s1 = E8; n1 = 1; s2 = 0; n2 = 0; s3 = 0; n3 = 0; s4 = 0; n4 = 0; s5 = 0; n5 = 0; }
    else if (stage == 5) { s0 = 0; n0 = 352; s1 = E5 + 72; n1 = 72; s2 = E6; n2 = E8 - E6; s3 = 0; n3 = 0; s4 = 0; n4 = 0; s5 = 0; n5 = 0; }
    else if (stage == 1) { s0 = E1; n0 = 176; s1 = E2; n1 = 144; s2 = E3; n2 = 128; s3 = 352; n3 = 352; s4 = 0; n4 = 0; s5 = 0; n5 = 0; }
    else if (stage == 2) { s0 = E1 + 176; n0 = 176; s1 = 704; n1 = 352; s2 = E2 + 144; n2 = 144; s3 = E3 + 128; n3 = 128; s4 = 0; n4 = 0; s5 = 0; n5 = 0; }
    else if (stage == 4) { s0 = 1056; n0 = 352; s1 = E1 + 528; n1 = 176; s2 = 0; n2 = 0; s3 = 0; n3 = 0; s4 = 0; n4 = 0; s5 = 0; n5 = 0; }
    else                 { s0 = E4; n0 = 160; s1 = E1 + 352; n1 = 176; s2 = 0; n2 = 0; s3 = 0; n3 = 0; s4 = 0; n4 = 0; s5 = 0; n5 = 0; }
    const int ntot = n0 + n1 + n2 + n3 + n4 + n5;
    for (int lj = rank; lj < ntot; lj += nblk) {
        int job, r = lj;
        if (r < n0) job = s0 + r; else { r -= n0;
        if (r < n1) job = s1 + r; else { r -= n1;
        if (r < n2) job = s2 + r; else { r -= n2;
        if (r < n3) job = s3 + r; else { r -= n3;
        if (r < n4) job = s4 + r; else { r -= n4; job = s5 + r; } } } } }
        if (job < E1) {
            const int mat = job / (16 * 22), r = job % (16 * 22), kt = r / 22, nt = r % 22;
            xpose_tile(lds, kin(9) + (size_t)mat * 1024 * 5632, 5632, kt * 64, nt * 256, 1, kt * 64, (bf16_t*)(ws + OFF_WGU + mat * SZ_WGU), 1024);
        } else if (job < E2) {
            const int j = job - E1; const int mat = j / (44 * 4), r = j % (44 * 4), kt = r / 4, nt = r % 4;
            xpose_tile(lds, kin(10) + (size_t)mat * 2816 * 1024, 1024, kt * 64, nt * 256, 2, kt * 64, (bf16_t*)(ws + OFF_WDN + mat * SZ_WDN), 2816);
        } else if (job < E3) {
            const int j = job - E2; const int mat = j / (16 * 9), r = j % (16 * 9), kt = r / 9, nt = r % 9;
            xpose_tile(lds, kin(11) + (size_t)mat * 1024 * 2560, 2560, kt * 64, nt * 256, nt >= 6 ? 2 : 0, kt * 64, (bf16_t*)(ws + OFF_WIN + mat * SZ_WIN), 1024);
        } else if (job < E4) {
            const int j = job - E3; const int mat = j / 128, r = j % 128, kt = r / 8, gsel = r % 8, g = gsel >> 1, sn = gsel & 1;
            const float* src = kin(11) + (size_t)mat * 1024 * 2560; const int k0 = kt * 64;
            LAS float* tile = lds; LAS float* tw = lds + 64 * 65;
            { const int jj = tid & 63, kb = tid >> 6;
#pragma unroll
              for (int i = 0; i < 8; ++i) { const int kk = kb + 8 * i; tile[kk * 65 + jj] = src[(size_t)(k0 + kk) * 2560 + 2304 + g * 64 + jj]; } }
            if (tid < 64) tw[tid] = (sn ? sinpif((float)tid / 32.f) : cospif((float)tid / 32.f)) * 0.125f;
            __syncthreads();
            bf16_t* dst = (bf16_t*)(ws + OFF_WIN + mat * SZ_WIN);
            { const int kk2 = (tid & 31) * 2, cb = tid >> 5;
#pragma unroll 1
              for (int i = 0; i < 4; ++i) { const int cc = cb + 16 * i; float v0 = 0.f, v1 = 0.f;
#pragma unroll 4
                  for (int c2 = 0; c2 < 64; ++c2) { const float w = tw[(c2 * cc) & 63]; v0 += tile[kk2 * 65 + c2] * w; v1 += tile[(kk2 + 1) * 65 + c2] * w; }
                  *(unsigned*)(dst + (size_t)(2304 + sn * 256 + g * 64 + cc) * 1024 + k0 + kk2) = pack_bf16(v0, v1); } }
            __syncthreads();
        } else if (job < E5) {
            const int j = job - E4; const int mat = j / 80, r = j % 80, kt = r / 4, nt = r % 4;
            xpose_tile(lds, kin(12) + (size_t)mat * 1024 * 1024, 1024, kt < 16 ? kt * 64 : 768 + (kt - 16) * 64, nt * 256, 2, kt * 64, (bf16_t*)(ws + OFF_WOUT + mat * SZ_WOUT), 1280);
        } else if (job < E6) {
            const int j = job - E5; const int l = j / 72, col0 = (j % 72) * 128;
            LAS float* sl = lds;
            LAS float* red = lds + 5 * 1024;
            { float cv[10]; const float* c4p = kin(4); const float* c5p = kin(5);
#pragma unroll
              for (int q = 0; q < 10; ++q) { const int i = tid + 512 * q, v = i >> 10, k = i & 1023; cv[q] = v == 0 ? c5p[k] : c4p[(v - 1) * 1024 + k]; }
              __builtin_amdgcn_sched_barrier(0);
#pragma unroll
              for (int q = 0; q < 10; ++q) sl[tid + 512 * q] = cv[q] / (1.f + __expf(-cv[q])); }
            __syncthreads();
            const int cgp = tid & 31, kc = tid >> 5;
            f32x4 a[5];
#pragma unroll
            for (int v = 0; v < 5; ++v) a[v] = (f32x4){0.f, 0.f, 0.f, 0.f};
            const float* wp = kin(6) + (size_t)l * 1024 * 9216 + col0 + 4 * cgp;
            for (int kk0 = 0; kk0 < 64; kk0 += 16) {
                f32x4 wv[16];
#pragma unroll
                for (int uu = 0; uu < 16; ++uu) wv[uu] = *(const f32x4*)(wp + (size_t)(kc * 64 + kk0 + uu) * 9216);
                __builtin_amdgcn_sched_barrier(0);
#pragma unroll
                for (int uu = 0; uu < 16; ++uu) { const int k = kc * 64 + kk0 + uu;
#pragma unroll
                    for (int v = 0; v < 5; ++v) { const float s = sl[v * 1024 + k]; a[v] += wv[uu] * s; } }
            }
#pragma unroll
            for (int v = 0; v < 5; ++v) *(LAS f32x4*)(red + (kc * 5 + v) * 128 + 4 * cgp) = a[v];
            __syncthreads();
            const float* bmp = kin(7);
            for (int i = tid; i < 5 * 128; i += 512) { const int v = i / 128, cc = i % 128; float s = bmp[l * 9216 + col0 + cc];
                for (int q = 0; q < 16; ++q) s += red[(q * 5 + v) * 128 + cc];
                ((float*)(ws + OFF_MOD))[(size_t)(l * 5 + v) * 9216 + col0 + cc] = s; }
            __syncthreads();
        } else if (job < E7) {
            const int j = job - E6; bf16_t* D = (bf16_t*)(ws + OFF_DLAT); const float sc = 0.02209708691f;
            LAS float* tc = lds; LAS float* tsn = lds + 2048;
#pragma unroll 1
            for (int i = tid; i < 2048; i += 512) { float sv, cv; sincospif((float)i * (1.f / 1024.f), &sv, &cv); tc[i] = cv * sc; tsn[i] = -sv * sc; }
            __syncthreads();
#pragma unroll 2
            for (int i = tid; i < 8 * 1024; i += 512) { const int np = j * 8 + (i >> 10), n = (i & 1023) * 2;
                const int m0 = (np * n) & 2047, m1 = (np * (n + 1)) & 2047;
                *(unsigned*)(D + (size_t)np * 2048 + n) = pack_bf16(tc[m0], tc[m1]);
                *(unsigned*)(D + (size_t)2048 * 2048 + (size_t)np * 2048 + n) = pack_bf16(tsn[m0], tsn[m1]); }
            __syncthreads();
        } else if (job < E8) {
            const int j = job - E7; bf16_t* D = (bf16_t*)(ws + OFF_DCTX); const float sc = 0.0625f;
#pragma unroll 1
            for (int i = tid; i < 32 * 128; i += 512) { const int np = j * 32 + (i >> 7), n = (i & 127) * 2;
                const int m0 = (np * n) & 255, m1 = (np * (n + 1)) & 255;
                float s0, c0, s1, c1; sincospif((float)m0 * (1.f / 128.f), &s0, &c0); sincospif((float)m1 * (1.f / 128.f), &s1, &c1);
                *(unsigned*)(D + (size_t)np * 256 + n) = pack_bf16(c0 * sc, c1 * sc);
                *(unsigned*)(D + (size_t)256 * 256 + (size_t)np * 256 + n) = pack_bf16(-s0 * sc, -s1 * sc); }
        } else {
            float* rc = (float*)(ws + OFF_ROPE); float* rs = rc + 1024;
#pragma unroll 1
            for (int i = tid; i < 1024; i += 512) { const int pos = i >> 4, f = i & 15; const float inv = 1.0f / powf(10000.0f, (float)f / 16.0f); const float ang = (float)pos * inv; rc[i] = cosf(ang); rs[i] = sinf(ang); }
            if (tid < 2) { const float* lq = kin(14) + tid * 256; float d0 = 0.f, d1 = 0.f; for (int i = 0; i < 64; ++i) { d0 += lq[i] * lq[64 + i]; d1 += lq[128 + i] * lq[192 + i]; }
                const float li = 0.8f - 0.6f * expf(-0.3f * (float)tid); ((float*)(ws + OFF_MISC))[tid] = expf(d0) - expf(d1) + li; ((float*)(ws + OFF_MISC))[2 + tid] = li; }
        }
    }
}

__device__ __forceinline__ void unpack8(const u32x4 a, f32x4& lo, f32x4& hi) { lo = (f32x4){bf_lo(a.x), bf_hi(a.x), bf_lo(a.y), bf_hi(a.y)}; hi = (f32x4){bf_lo(a.z), bf_hi(a.z), bf_lo(a.w), bf_hi(a.w)}; }
__device__ __forceinline__ u32x4 pack8(const f32x4 lo, const f32x4 hi) { u32x4 p; p.x = pack_bf16(lo[0], lo[1]); p.y = pack_bf16(lo[2], lo[3]); p.z = pack_bf16(hi[0], hi[1]); p.w = pack_bf16(hi[2], hi[3]); return p; }
__device__ __forceinline__ void row_phase(int lprev, int sprev, float rw, int lnext, int snext) {
    const int tid = tid_now(), wave = tid >> 6, lane = tid & 63;
    float* XO = kout(); unsigned char* ws = kws();
    const bf16_t* Y = (const bf16_t*)(ws + OFF_Y); bf16_t* H = (bf16_t*)(ws + OFF_H); bf16_t* XB = (bf16_t*)(ws + OFF_XB);
    const float* MOD = (const float*)(ws + OFF_MOD); const float* NG = kin(8);
    const float* xin0 = kin(0); const float* xin1 = kin(1);
    const int nwave = gridDim.x * 8, RW = NTOK / nwave, gw = blockIdx.x * 8 + wave;
    const int rbase = gw * RW;
    const int v = rbase < NCTX ? 0 : 1 + ((rbase - NCTX) >> 11);
    f32x4 vgate[4], vgpost[4], vsh[4], vsc[4], vgpre[4];
    if (lprev >= 0) { const float* gate = MOD + (size_t)(lprev * 5 + v) * 9216 + (3 * sprev + 2) * 1024; const float* gp = NG + (lprev * 6 + 2 * sprev + 1) * 1024;
#pragma unroll
        for (int q = 0; q < 4; ++q) { const int col = 512 * (q >> 1) + 8 * lane + 4 * (q & 1); vgate[q] = *(const f32x4*)(gate + col) * rw; vgpost[q] = *(const f32x4*)(gp + col); } }
    if (lnext >= 0) { const float* sh = MOD + (size_t)(lnext * 5 + v) * 9216 + (3 * snext) * 1024; const float* scp = sh + 1024; const float* gp = NG + (lnext * 6 + 2 * snext) * 1024;
#pragma unroll
        for (int q = 0; q < 4; ++q) { const int col = 512 * (q >> 1) + 8 * lane + 4 * (q & 1); vsh[q] = *(const f32x4*)(sh + col); vsc[q] = *(const f32x4*)(scp + col) + 1.f; vgpre[q] = *(const f32x4*)(gp + col); } }
    for (int j = 0; j < RW; j += 2) {
        int rows[2]; rows[0] = rbase + j; rows[1] = j + 1 < RW ? rbase + j + 1 : rbase + j;
        f32x4 x[2][4], y[2][4];
        u32x4 rx[2][2], ry[2][2];
#pragma unroll
        for (int u = 0; u < 2; ++u) {
            const int row = rows[u];
            if (lprev < 0) { const float* src = row < NCTX ? xin0 + (size_t)row * 1024 : xin1 + (size_t)(row - NCTX) * 1024;
#pragma unroll
                for (int q = 0; q < 4; ++q) x[u][q] = *(const f32x4*)(src + 512 * (q >> 1) + 8 * lane + 4 * (q & 1));
            } else {
#pragma unroll
                for (int i = 0; i < 2; ++i) rx[u][i] = *(const u32x4*)(XB + (size_t)row * 1024 + 512 * i + 8 * lane);
#pragma unroll
                for (int i = 0; i < 2; ++i) ry[u][i] = *(const u32x4*)(Y + (size_t)row * 1024 + 512 * i + 8 * lane);
            }
        }
        __builtin_amdgcn_sched_barrier(0);
        if (lprev >= 0) {
#pragma unroll
            for (int u = 0; u < 2; ++u)
#pragma unroll
                for (int i = 0; i < 2; ++i) { unpack8(rx[u][i], x[u][2 * i], x[u][2 * i + 1]); unpack8(ry[u][i], y[u][2 * i], y[u][2 * i + 1]); }
        }
#pragma unroll
        for (int u = 0; u < 2; ++u) {
            const int row = rows[u];
            if (lprev >= 0) {
                float ss = 0.f;
#pragma unroll
                for (int q = 0; q < 4; ++q) ss += y[u][q][0] * y[u][q][0] + y[u][q][1] * y[u][q][1] + y[u][q][2] * y[u][q][2] + y[u][q][3] * y[u][q][3];
                ss = wave_sum(ss, lane); const float r = rsqrtf(ss * (1.f / 1024.f) + 1e-6f);
#pragma unroll
                for (int q = 0; q < 4; ++q) x[u][q] += vgate[q] * (y[u][q] * r * vgpost[q]);
            }
            if (lnext < 0) {
#pragma unroll
                for (int q = 0; q < 4; ++q) *(f32x4*)(XO + (size_t)row * 1024 + 512 * (q >> 1) + 8 * lane + 4 * (q & 1)) = x[u][q];
            } else {
#pragma unroll
                for (int i = 0; i < 2; ++i) *(u32x4*)(XB + (size_t)row * 1024 + 512 * i + 8 * lane) = pack8(x[u][2 * i], x[u][2 * i + 1]);
                float ss = 0.f;
#pragma unroll
                for (int q = 0; q < 4; ++q) ss += x[u][q][0] * x[u][q][0] + x[u][q][1] * x[u][q][1] + x[u][q][2] * x[u][q][2] + x[u][q][3] * x[u][q][3];
                ss = wave_sum(ss, lane); const float r = rsqrtf(ss * (1.f / 1024.f) + 1e-6f);
                f32x4 h[4];
#pragma unroll
                for (int q = 0; q < 4; ++q) h[q] = x[u][q] * r * vgpre[q] * vsc[q] + vsh[q];
#pragma unroll
                for (int i = 0; i < 2; ++i) *(u32x4*)(H + (size_t)row * 1024 + 512 * i + 8 * lane) = pack8(h[2 * i], h[2 * i + 1]);
            }
        }
    }
}

__device__ __forceinline__ void cache_convert(int l, LAS unsigned char* lds) {
    unsigned char* ws = kws(); const int tid = tid_now(); const int gt = blockIdx.x * 512 + tid, gs = gridDim.x * 512;
    bf16_t* KL = (bf16_t*)(ws + OFF_KL); bf16_t* VTL = (bf16_t*)(ws + OFF_VTL);
    const float* ckp = kin(2); const float* cvp = kin(3);
    for (int i = gt; i < 4 * 512 * 4 * 32; i += gs) {
        const int c4 = i & 31, h = (i >> 5) & 3, s = (i >> 7) & 511, b = i >> 16;
        const f32x4 v = *(const f32x4*)(ckp + ((((size_t)b * 2 + l) * 512 + s) * 4 + h) * 128 + c4 * 4);
        u32x2 pk; pk.x = pack_bf16(v[0], v[1]); pk.y = pack_bf16(v[2], v[3]);
        *(u32x2*)(KL + ((size_t)(b * 4 + h) * 2560 + 2048 + s) * 128 + c4 * 4) = pk;
    }
    constexpr int S = 136;
    for (int job = blockIdx.x; job < 128; job += gridDim.x) {
        const int kt = job & 7, h = (job >> 3) & 3, b = job >> 5;
        const int e4 = tid & 31, kb = tid >> 5;
        __syncthreads();
        f32x4 rv[4];
#pragma unroll
        for (int i = 0; i < 4; ++i) rv[i] = *(const f32x4*)(cvp + ((((size_t)b * 2 + l) * 512 + kt * 64 + kb + 16 * i) * 4 + h) * 128 + e4 * 4);
        __builtin_amdgcn_sched_barrier(0);
#pragma unroll
        for (int i = 0; i < 4; ++i) { const int key = kb + 16 * i;
            const f32x4 v = rv[i];
            const unsigned p01 = pack_bf16(v[0], v[1]), p23 = pack_bf16(v[2], v[3]);
            LAS unsigned char* t0 = lds + (4 * e4) * S + key * 2;
            *(LAS bf16_t*)t0 = (bf16_t)(p01 & 0xffff); *(LAS bf16_t*)(t0 + S) = (bf16_t)(p01 >> 16); *(LAS bf16_t*)(t0 + 2 * S) = (bf16_t)(p23 & 0xffff); *(LAS bf16_t*)(t0 + 3 * S) = (bf16_t)(p23 >> 16); }
        __syncthreads();
        { const int e = tid >> 2, q = tid & 3; const LAS unsigned char* r = lds + e * S + q * 32;
          bf16_t* dst = VTL + ((size_t)(b * 4 + h) * 128 + e) * 2560 + 2048 + kt * 64 + 32 * (q >> 1) + 4 * (q & 1);
#pragma unroll
          for (int g = 0; g < 4; ++g) *(u32x2*)(dst + 8 * g) = *(const LAS u32x2*)(r + g * 8); }
    }
}

constexpr int KSTR = 272, VSTR = 128;
constexpr int KT_BYTES = 64 * KSTR, VT_BYTES = 128 * VSTR;

__device__ __forceinline__ void attn_item(int item, int layer, LAS unsigned char* lds) {
    const int tid = tid_now(), wave = tid >> 6, lane = tid & 63, fr = lane & 15, g = lane >> 4;
    unsigned char* ws = kws();
    const bool lat = item < 256;
    int b, h, qb; if (lat) { b = item >> 6; h = (item >> 4) & 3; qb = item & 15; } else { const int j = item - 256; b = j >> 3; h = (j >> 1) & 3; qb = j & 1; }
    const int L = lat ? 2560 : 256, seq = lat ? 2048 : 256;
    const int tokb = lat ? NCTX + b * 2048 : b * 256;
    const int tok0 = tokb + qb * 128;
    const bf16_t* Kb = lat ? (const bf16_t*)(ws + OFF_KL) + (size_t)(b * 4 + h) * 2560 * 128 : (const bf16_t*)(ws + OFF_KC) + (size_t)(b * 4 + h) * 256 * 128;
    const bf16_t* Vb = lat ? (const bf16_t*)(ws + OFF_VTL) + (size_t)(b * 4 + h) * 128 * 2560 : (const bf16_t*)(ws + OFF_VTC) + (size_t)(b * 4 + h) * 128 * 256;
    const float lam = ((const float*)(ws + OFF_MISC))[layer], lam_init = ((const float*)(ws + OFF_MISC))[2 + layer];
    bf16_t* CAT = (bf16_t*)(ws + OFF_CAT);

    {
        const bf16_t* GB = (const bf16_t*)(ws + OFF_CONV); const bf16_t* GC = GB + (size_t)NTOK * 256; const bf16_t* HC = GC + (size_t)NTOK * 256;
        const float* cw = kin(13) + layer * 768;
        const int c4 = (tid & 15) * 4 + h * 64, tb = tid >> 4;
        const f32x4 w0 = *(const f32x4*)(cw + c4), w1 = *(const f32x4*)(cw + 256 + c4), w2 = *(const f32x4*)(cw + 512 + c4);
#pragma unroll
        for (int i = 0; i < 4; ++i) {
            const int tl = qb * 128 + tb + 32 * i;
            const size_t t = (size_t)(tokb + tl);
            f32x4 um = (f32x4){0.f, 0.f, 0.f, 0.f}, up = um, u0;
            { const u32x2 a = *(const u32x2*)(GC + t * 256 + c4), c = *(const u32x2*)(HC + t * 256 + c4);
              u0 = (f32x4){bf_lo(a.x) * bf_lo(c.x), bf_hi(a.x) * bf_hi(c.x), bf_lo(a.y) * bf_lo(c.y), bf_hi(a.y) * bf_hi(c.y)}; }
            if (tl > 0) { const u32x2 a = *(const u32x2*)(GC + (t - 1) * 256 + c4), c = *(const u32x2*)(HC + (t - 1) * 256 + c4);
              um = (f32x4){bf_lo(a.x) * bf_lo(c.x), bf_hi(a.x) * bf_hi(c.x), bf_lo(a.y) * bf_lo(c.y), bf_hi(a.y) * bf_hi(c.y)}; }
            if (tl < seq - 1) { const u32x2 a = *(const u32x2*)(GC + (t + 1) * 256 + c4), c = *(const u32x2*)(HC + (t + 1) * 256 + c4);
              up = (f32x4){bf_lo(a.x) * bf_lo(c.x), bf_hi(a.x) * bf_hi(c.x), bf_lo(a.y) * bf_lo(c.y), bf_hi(a.y) * bf_hi(c.y)}; }
            const u32x2 gbu = *(const u32x2*)(GB + t * 256 + c4);
            const f32x4 gbv = (f32x4){bf_lo(gbu.x), bf_hi(gbu.x), bf_lo(gbu.y), bf_hi(gbu.y)};
            const f32x4 o = gbv * (um * w0 + u0 * w1 + up * w2);
            u32x2 pk; pk.x = pack_bf16(o[0], o[1]); pk.y = pack_bf16(o[2], o[3]);
            *(u32x2*)(CAT + t * 1280 + 512 + c4) = pk;
        }
    }

    if (wave < 4) __builtin_amdgcn_s_setprio(2); else __builtin_amdgcn_s_setprio(0);
    const int qtok = tok0 + wave * 16 + fr;
    bf16x8 qf[2][2];
#pragma unroll
    for (int m = 0; m < 2; ++m)
#pragma unroll
        for (int ks = 0; ks < 2; ++ks) qf[m][ks] = *(const bf16x8*)((const bf16_t*)(ws + OFF_Q) + (size_t)qtok * 512 + h * 128 + m * 64 + ks * 32 + g * 8);

    LAS unsigned char* Kt[2] = {lds, lds + KT_BYTES};
    LAS unsigned char* Vt[2] = {lds + 2 * KT_BYTES, lds + 2 * KT_BYTES + VT_BYTES};
    const int skey = tid >> 3, sseg = tid & 7;
    const int ve = tid >> 2, vseg = tid & 3;
    const int vsw = (ve >> 1) & 7;
    const int vw0 = ve * 128 + (((2 * vseg) ^ vsw) << 4), vw1 = ve * 128 + (((2 * vseg + 1) ^ vsw) << 4);
    const int kro = fr * KSTR + g * 16;
    const int rsw = (fr >> 1) & 7;
    const int vro0 = fr * 128 + ((g ^ rsw) << 4), vro1 = fr * 128 + (((4 + g) ^ rsw) << 4);
    const int ntile = L / 64;

#define ATT_RDK(dst, base, c2) do { _Pragma("unroll") for (int sub = 0; sub < 2; ++sub) _Pragma("unroll") for (int m = 0; m < 2; ++m) _Pragma("unroll") for (int ks = 0; ks < 2; ++ks) \
        dst[sub][m][ks] = *(const LAS bf16x8*)((base) + ((c2) * 2 + sub) * 16 * KSTR + kro + m * 128 + ks * 64); } while (0)
#define ATT_QK(sdst, kf, i0_, i1_) do { _Pragma("unroll") for (int sub = 0; sub < 2; ++sub) _Pragma("unroll") for (int m = 0; m < 2; ++m) { f32x4 a_ = m ? i1_ : i0_; \
        _Pragma("unroll") for (int ks = 0; ks < 2; ++ks) a_ = __builtin_amdgcn_mfma_f32_16x16x32_bf16(kf[sub][m][ks], qf[m][ks], a_, 0, 0, 0); sdst[m][sub] = a_; } } while (0)

    float mrun[2] = {-INFINITY, -INFINITY};
    const f32x4 zero4 = (f32x4){0.f, 0.f, 0.f, 0.f};
#define ATT_LDK(k0_, k1_, tt) do { const bf16_t* src_ = Kb + (size_t)((tt) * 64 + skey) * 128 + sseg * 16; k0_ = *(const u32x4*)src_; k1_ = *(const u32x4*)(src_ + 8); } while (0)
#define ATT_WRK(k0_, k1_, bi) do { LAS unsigned char* d_ = Kt[bi] + skey * KSTR + sseg * 32; *(LAS u32x4*)d_ = k0_; *(LAS u32x4*)(d_ + 16) = k1_; } while (0)
#define ATT_P1(bi) do { const LAS unsigned char* kt_ = Kt[bi]; \
            bf16x8 kfA[2][2][2], kfB[2][2][2]; ATT_RDK(kfA, kt_, 0); ATT_RDK(kfB, kt_, 1); __builtin_amdgcn_sched_barrier(0); \
            f32x4 sA[2][2], sB[2][2]; ATT_QK(sA, kfA, zero4, zero4); ATT_QK(sB, kfB, zero4, zero4); __builtin_amdgcn_sched_barrier(0); \
            _Pragma("unroll") for (int m = 0; m < 2; ++m) { \
                    const f32x4 v0 = sA[m][0], v1 = sA[m][1], v2 = sB[m][0], v3 = sB[m][1]; \
                    const float t0 = fmaxf(fmaxf(fmaxf(v0[0], v0[1]), fmaxf(v0[2], v0[3])), fmaxf(fmaxf(v1[0], v1[1]), fmaxf(v1[2], v1[3]))); \
                    const float t1 = fmaxf(fmaxf(fmaxf(v2[0], v2[1]), fmaxf(v2[2], v2[3])), fmaxf(fmaxf(v3[0], v3[1]), fmaxf(v3[2], v3[3]))); \
                    mrun[m] = fmaxf(mrun[m], fmaxf(t0, t1)); } } while (0)
    float bnd[2];
    {
        float km = 0.f;
        for (int t0 = 0; t0 < ntile; t0 += 4) {
            u32x4 ra[4], rb[4];
#pragma unroll
            for (int tt = 0; tt < 4; ++tt) { const bf16_t* src_ = Kb + (size_t)((t0 + tt) * 64 + skey) * 128 + sseg * 16; ra[tt] = *(const u32x4*)src_; rb[tt] = *(const u32x4*)(src_ + 8); }
            __builtin_amdgcn_sched_barrier(0);
#pragma unroll
            for (int tt = 0; tt < 4; ++tt) {
                const u32x4 a = ra[tt], b2 = rb[tt];
                float ss = 0.f;
                { const unsigned w[8] = {a.x, a.y, a.z, a.w, b2.x, b2.y, b2.z, b2.w};
#pragma unroll
                  for (int i = 0; i < 8; ++i) { const float lo = bf_lo(w[i]), hi = bf_hi(w[i]); ss += lo * lo + hi * hi; } }
                ss += dppf<0xB1>(ss); ss += dppf<0x4E>(ss);
                km = fmaxf(km, ss);
            }
        }
        km = fmaxf(km, shflx(km, 8, lane)); km = fmaxf(km, shflx(km, 16, lane)); km = fmaxf(km, shflx(km, 32, lane));
        volatile LAS float* red = (volatile LAS float*)(lds + 100000);
        __syncthreads();
        if ((lane & 59) == 0) red[wave * 2 + (lane >> 2)] = km;
        __syncthreads();
        float k2[2];
#pragma unroll
        for (int m = 0; m < 2; ++m) { float v = red[m]; for (int w = 1; w < 8; ++w) v = fmaxf(v, red[w * 2 + m]); k2[m] = v; }
        float bw = 0.f;
#pragma unroll
        for (int m = 0; m < 2; ++m) {
            float q2 = 0.f;
#pragma unroll
            for (int ks = 0; ks < 2; ++ks) { u32x4 u; __builtin_memcpy(&u, &qf[m][ks], 16); const unsigned w[4] = {u.x, u.y, u.z, u.w};
#pragma unroll
                for (int i = 0; i < 4; ++i) { const float lo = bf_lo(w[i]), hi = bf_hi(w[i]); q2 += lo * lo + hi * hi; } }
            q2 += shflx(q2, 16, lane); q2 += shflx(q2, 32, lane);
            bnd[m] = sqrtf(q2 * k2[m]) * 1.001f + 1e-3f; bw = fmaxf(bw, bnd[m]);
        }
        bw = fmaxf(bw, shflx(bw, 1, lane)); bw = fmaxf(bw, shflx(bw, 2, lane)); bw = fmaxf(bw, shflx(bw, 4, lane)); bw = fmaxf(bw, shflx(bw, 8, lane));
        __syncthreads();
        if (lane == 0) red[16 + wave] = bw;
        __syncthreads();
        float ball = red[16]; for (int w = 1; w < 8; ++w) ball = fmaxf(ball, red[16 + w]);
        bnd[0] = (ball > 60.f || (kp4()->probe & 256)) ? -1.f : bnd[0];
    }
    const bool exact = bnd[0] < 0.f;
    if (exact) {
        mrun[0] = mrun[1] = -INFINITY;
        u32x4 ka0, ka1;
        ATT_LDK(ka0, ka1, 0); ATT_WRK(ka0, ka1, 0);
        __syncthreads();
        for (int t = 0; t < ntile; ++t) {
            if (t + 1 < ntile) ATT_LDK(ka0, ka1, t + 1);
            ATT_P1(t & 1);
            if (t + 1 < ntile) ATT_WRK(ka0, ka1, (t + 1) & 1);
            __syncthreads();
        }
    }
    f32x4 negM[2];
#pragma unroll
    for (int m = 0; m < 2; ++m) { float mx = fmaxf(mrun[m], shflx(mrun[m], 16, lane)); mx = fmaxf(mx, shflx(mx, 32, lane)); if (!exact) mx = bnd[m]; negM[m] = (f32x4){-mx, -mx, -mx, -mx}; }
    f32x4 o0[8], o1[8]; float lsum[2] = {0.f, 0.f};
#pragma unroll
    for (int et = 0; et < 8; ++et) { o0[et] = zero4; o1[et] = zero4; }
#define ATT_SOFTMAX(pb0, pb1, sx) do { float e0_[8], e1_[8]; _Pragma("unroll") for (int sub = 0; sub < 2; ++sub) _Pragma("unroll") for (int j = 0; j < 4; ++j) { \
        e0_[sub * 4 + j] = __builtin_amdgcn_exp2f(sx[0][sub][j]); e1_[sub * 4 + j] = __builtin_amdgcn_exp2f(sx[1][sub][j]); } \
        lsum[0] += ((e0_[0] + e0_[1]) + (e0_[2] + e0_[3])) + ((e0_[4] + e0_[5]) + (e0_[6] + e0_[7])); lsum[1] += ((e1_[0] + e1_[1]) + (e1_[2] + e1_[3])) + ((e1_[4] + e1_[5]) + (e1_[6] + e1_[7])); \
        u32x4 pk_; pk_.x = pack_bf16_t(e0_[0], e0_[1]); pk_.y = pack_bf16_t(e0_[2], e0_[3]); pk_.z = pack_bf16_t(e0_[4], e0_[5]); pk_.w = pack_bf16_t(e0_[6], e0_[7]); __builtin_memcpy(&pb0, &pk_, 16); \
        pk_.x = pack_bf16_t(e1_[0], e1_[1]); pk_.y = pack_bf16_t(e1_[2], e1_[3]); pk_.z = pack_bf16_t(e1_[4], e1_[5]); pk_.w = pack_bf16_t(e1_[6], e1_[7]); __builtin_memcpy(&pb1, &pk_, 16); } while (0)
#define ATT_LDV(v0_, v1_, tt) do { const bf16_t* vs_ = Vb + (size_t)ve * L + (tt) * 64 + vseg * 16; v0_ = *(const u32x4*)vs_; v1_ = *(const u32x4*)(vs_ + 8); } while (0)
#define ATT_WRV(v0_, v1_, bi) do { *(LAS u32x4*)(Vt[bi] + vw0) = v0_; *(LAS u32x4*)(Vt[bi] + vw1) = v1_; } while (0)
#define ATT_P2(bi) do { const LAS unsigned char* kt_ = Kt[bi]; const LAS unsigned char* vt_ = Vt[bi]; \
            f32x4 sA[2][2], sB[2][2]; \
            { bf16x8 kfA[2][2][2], kfB[2][2][2]; ATT_RDK(kfA, kt_, 0); ATT_RDK(kfB, kt_, 1); __builtin_amdgcn_sched_barrier(0); \
              ATT_QK(sA, kfA, negM[0], negM[1]); ATT_QK(sB, kfB, negM[0], negM[1]); } __builtin_amdgcn_sched_barrier(0); \
            bf16x8 vfA[8], vfB[8], pA0, pA1, pB0, pB1; \
            _Pragma("unroll") for (int et = 0; et < 8; ++et) vfA[et] = *(const LAS bf16x8*)(vt_ + et * 2048 + vro0); \
            ATT_SOFTMAX(pA0, pA1, sA); __builtin_amdgcn_sched_barrier(0); \
            _Pragma("unroll") for (int et = 0; et < 8; ++et) vfB[et] = *(const LAS bf16x8*)(vt_ + et * 2048 + vro1); \
            _Pragma("unroll") for (int et = 0; et < 8; ++et) { o0[et] = __builtin_amdgcn_mfma_f32_16x16x32_bf16(vfA[et], pA0, o0[et], 0, 0, 0); o1[et] = __builtin_amdgcn_mfma_f32_16x16x32_bf16(vfA[et], pA1, o1[et], 0, 0, 0); } \
            ATT_SOFTMAX(pB0, pB1, sB); __builtin_amdgcn_sched_barrier(0); \
            _Pragma("unroll") for (int et = 0; et < 8; ++et) { o0[et] = __builtin_amdgcn_mfma_f32_16x16x32_bf16(vfB[et], pB0, o0[et], 0, 0, 0); o1[et] = __builtin_amdgcn_mfma_f32_16x16x32_bf16(vfB[et], pB1, o1[et], 0, 0, 0); } } while (0)
    {
        u32x4 ka0, ka1, va0, va1;
        ATT_LDK(ka0, ka1, 0); ATT_LDV(va0, va1, 0); ATT_WRK(ka0, ka1, 0); ATT_WRV(va0, va1, 0);
        __syncthreads();
        for (int t = 0; t < ntile; ++t) {
            if (t + 1 < ntile) { ATT_LDK(ka0, ka1, t + 1); ATT_LDV(va0, va1, t + 1); }
            ATT_P2(t & 1);
            if (t + 1 < ntile) { ATT_WRK(ka0, ka1, (t + 1) & 1); ATT_WRV(va0, va1, (t + 1) & 1); }
            __syncthreads();
        }
    }
#undef ATT_LDK
#undef ATT_WRK
#undef ATT_LDV
#undef ATT_WRV
#undef ATT_P1
#undef ATT_P2
#undef ATT_RDK
#undef ATT_QK
#undef ATT_SOFTMAX
    __builtin_amdgcn_s_setprio(0);
    float c0, c1;
    { float l0 = lsum[0]; l0 += shflx(l0, 16, lane); l0 += shflx(l0, 32, lane); float l1 = lsum[1]; l1 += shflx(l1, 16, lane); l1 += shflx(l1, 32, lane); c0 = 1.f / l0; c1 = lam / l1; }
    f32x4 o[8];
#pragma unroll
    for (int et = 0; et < 8; ++et) o[et] = o0[et] * c0 - o1[et] * c1;
    float ss = 0.f;
#pragma unroll
    for (int et = 0; et < 8; ++et) ss += o[et][0] * o[et][0] + o[et][1] * o[et][1] + o[et][2] * o[et][2] + o[et][3] * o[et][3];
    ss += shflx(ss, 16, lane); ss += shflx(ss, 32, lane);
    const float r = rsqrtf(ss * (1.f / 128.f) + 1e-6f) * (1.f - lam_init);
    const float* sg = kin(15) + layer * 128;
    f32x4 ggv[8];
#pragma unroll
    for (int et = 0; et < 8; ++et) ggv[et] = *(const f32x4*)(sg + et * 16 + 4 * g);
    __builtin_amdgcn_sched_barrier(0);
#pragma unroll
    for (int et = 0; et < 8; ++et) { const f32x4 gg = ggv[et]; const f32x4 v = o[et] * r * gg;
        u32x2 pk; pk.x = pack_bf16(v[0], v[1]); pk.y = pack_bf16(v[2], v[3]);
        *(u32x2*)(CAT + (size_t)qtok * 1280 + h * 128 + et * 16 + 4 * g) = pk; }
}

#define XB_TMO      128
#define XB_XCNT(j)  (256  + 64 * (j))
#define XB_XSUB(j)  (1280 + 64 * (j))
#define XB_XGEN(j)  (2304 + 64 * (j))
#define XB_TOP      3328
#define XB_TOPGEN   3392
#define XB_SPIN_CAP (1u << 18)
__device__ __forceinline__ unsigned xb_ld(unsigned* p)              { return __hip_atomic_load(p, __ATOMIC_RELAXED, __HIP_MEMORY_SCOPE_AGENT); }
__device__ __forceinline__ unsigned xb_add(unsigned* p, unsigned v) { return __hip_atomic_fetch_add(p, v, __ATOMIC_RELAXED, __HIP_MEMORY_SCOPE_AGENT); }
__device__ __forceinline__ unsigned xb_xcc_id() { return (unsigned)__builtin_amdgcn_s_getreg((3 << 11) | 20) & 0xFu; }
#define XB_SPIN(cond, bar) do { unsigned _sp = 0; while (cond) { __builtin_amdgcn_s_sleep(1); \
    if ((++_sp & 255u) == 0u) { if (xb_ld(&(bar)[XB_TMO])) break; if (_sp > XB_SPIN_CAP) { atomicAdd(&(bar)[XB_TMO], 1u); break; } } } } while (0)
__device__ __forceinline__ void xcd_barrier_complete(unsigned* bar, unsigned x, unsigned& nloc, unsigned& nx) {
    const unsigned G = gridDim.x;
    unsigned sum, cnt, mine, sp = 0u;
    for (;;) {
        sum = 0u; cnt = 0u; mine = 0u;
#pragma unroll
        for (unsigned j = 0; j < 16; ++j) { const unsigned c = xb_ld(&bar[XB_XCNT(j)]); sum += c; cnt += (c > 0u) ? 1u : 0u; mine = (j == x) ? c : mine; }
        if (sum == G) break;
        __builtin_amdgcn_s_sleep(1);
        if ((++sp & 255u) == 0u) { if (xb_ld(&bar[XB_TMO])) break; if (sp > XB_SPIN_CAP) { atomicAdd(&bar[XB_TMO], 1u); break; } }
    }
    nloc = mine > 0u ? mine : 1u; nx = cnt > 0u ? cnt : 1u;
}
__device__ __forceinline__ void xcd_barrier(unsigned* bar, volatile LAS unsigned* st) {
    asm volatile("s_waitcnt vmcnt(0)" ::: "memory");
    __syncthreads();
    if (tid_now() == 0) {
        const unsigned x = xb_xcc_id();
        __builtin_amdgcn_s_waitcnt(0);
        unsigned nloc = st[0], nx = st[1];
        if (nloc == 0u) { xcd_barrier_complete(bar, x, nloc, nx); st[0] = nloc; st[1] = nx; }
        const unsigned old = xb_add(&bar[XB_XSUB(x)], 1u);
        const unsigned gen = old / nloc;
        if (old + 1u == (gen + 1u) * nloc) {
            __builtin_amdgcn_fence(__ATOMIC_RELEASE, "agent");
            asm volatile("s_waitcnt vmcnt(0)" ::: "memory");
            const unsigned og = xb_add(&bar[XB_TOP], 1u);
            const unsigned tg = og / nx;
            if (og + 1u == (tg + 1u) * nx) xb_add(&bar[XB_TOPGEN], 1u);
            else XB_SPIN(xb_ld(&bar[XB_TOPGEN]) == tg, bar);
            __builtin_amdgcn_fence(__ATOMIC_ACQUIRE, "agent");
            xb_add(&bar[XB_XGEN(x)], 1u);
            asm volatile("s_waitcnt vmcnt(0)" ::: "memory");
        } else {
            XB_SPIN(xb_ld(&bar[XB_XGEN(x)]) == gen, bar);
            __builtin_amdgcn_fence(__ATOMIC_ACQUIRE, "agent");
            asm volatile("s_waitcnt vmcnt(0)" ::: "memory");
        }
    }
    __syncthreads();
}

__global__ void __launch_bounds__(512, 2) fwd_megakernel(Params p) {
    extern __shared__ __attribute__((aligned(16))) unsigned char shm[];
    LAS unsigned char* lds3 = (LAS unsigned char*)shm;
    const int ph_lo = kp4()->ph_lo, ph_hi = kp4()->ph_hi;
    {
        volatile LAS unsigned* st = (volatile LAS unsigned*)(lds3 + 131072 + 64);
        if (tid_now() == 0) { st[0] = 0u; st[1] = 0u; }
        __syncthreads();
    }
    int rep = 0;
    for (int ph = ph_lo; ph < ph_hi;) {
        unsigned char* ws = kws();
        bool again = false;
        { const int pmk = kp4()->probe; const int kk = ph < 2 ? -1 : (ph - 2) % 10;
            if (rep == 0 && (((pmk & 1) && ph == 0) || ((pmk & 2) && (kk == 3 || kk == 5)) || ((pmk & 4) && kk == 4) || ((pmk & 8) && (kk == 0 || kk == 7)) || ((pmk & 16) && (kk == 1 || kk == 8)) || ((pmk & 32) && ph == 1))) again = true; }
        int G = gridDim.x, c = blockIdx.x; asm volatile("" : "+s"(G), "+s"(c));
        if (ph <= 1) {
            if (ph == 0 && c == 0 && rep == 0) { unsigned* ctl = (unsigned*)(ws + OFF_CTL); for (int i = tid_now(); i < (int)(CTL_BYTES / 4); i += 512) ctl[i] = 0u; }
#ifndef DIS_ROW
            if (ph == 1) row_phase(-1, 0, 0.f, 0, 0);
#endif
#ifndef DIS_PREP
            {
                const int st0 = ph == 0 ? 0 : 5, st1 = ph == 0 ? (G != 256 ? 6 : 1) : (G != 256 ? 5 : 6);
                for (int st = st0; st < st1; ++st) prep_phase((LAS float*)lds3, st, c, G);
            }
#endif
        }
        else {
            const int l = (ph - 2) / 10, k = (ph - 2) % 10;
            if (k == 0 || k == 7) {
                const int s = k == 0 ? 0 : 1;
                pg8::StaticOrder S; S.init(NTOK, 2 * DFF, G, c);
                EpiSwiglu E; E.dummy = 0;
#ifndef DIS_G1
                pg8::gemm_phase(lds3, pg8::Gemm{(const bf16_t*)(ws + OFF_H), (const bf16_t*)(ws + OFF_WGU + (size_t)(l * 2 + s) * SZ_WGU), NTOK, 2 * DFF, 1024}, S, E);
#endif
                if (rep == 0 && c >= 128 && G == 256 && (l == 0 || k == 0)) prep_phase((LAS float*)lds3, l == 1 ? 4 : (k == 0 ? 1 : 2), c - 128, 128);
            } else if (k == 1 || k == 8 || k == 5) {
                pg8::Gemm gm;
                if (k == 5) gm = pg8::Gemm{(const bf16_t*)(ws + OFF_CAT), (const bf16_t*)(ws + OFF_WOUT + (size_t)l * SZ_WOUT), NTOK, 1024, 1280};
                else gm = pg8::Gemm{(const bf16_t*)(ws + OFF_ACT), (const bf16_t*)(ws + OFF_WDN + (size_t)(l * 2 + (k == 1 ? 0 : 1)) * SZ_WDN), NTOK, 1024, DFF};
                pg8::StaticOrder S; S.init(NTOK, 1024, G, c);
                EpiY E; E.ldc = 1024;
#ifndef DIS_GY
                pg8::gemm_phase(lds3, gm, S, E);
#endif
            } else if (k == 2) { row_phase(l, 0, 0.5f, l, 1); cache_convert(l, lds3); }
            else if (k == 3) {
                pg8::StaticOrder S; S.init(NTOK, NIN, G, c);
                EpiIn E; E.layer = l;
#ifndef DIS_GIN
                pg8::gemm_phase(lds3, pg8::Gemm{(const bf16_t*)(ws + OFF_H), (const bf16_t*)(ws + OFF_WIN + (size_t)l * SZ_WIN), NTOK, NIN, 1024}, S, E);
#endif
                if (l == 0 && rep == 0 && c >= 192 && G == 256) prep_phase((LAS float*)lds3, 3, c - 192, 64);
            } else if (k == 4) {
                const int pmx = kp4()->probe;
                if (c < 128 && !(rep == 1 && (pmx & 64))) {
                    const bool lt = c < 64; const int cc = c & 63, part = cc >> 5, uu = cc & 31;
                    pg8::OneUnit S; S.valid = 1; S.pm = lt ? (uu & 7) : 0; S.pn = lt ? (uu >> 3) : uu;
                    EpiDft E; E.tokbase = lt ? NCTX : 0; E.seqlen = lt ? 2048 : 256; E.coloff = 768 + part * 256;
                    pg8::Gemm gm = lt ? pg8::Gemm{(const bf16_t*)(ws + OFF_DLAT) + (size_t)part * 2048 * 2048, (const bf16_t*)(ws + OFF_FTL) + (size_t)part * 1024 * 2048, 2048, 1024, 2048}
                                      : pg8::Gemm{(const bf16_t*)(ws + OFF_DCTX) + (size_t)part * 256 * 256, (const bf16_t*)(ws + OFF_FTC) + (size_t)part * 8192 * 256, 256, 8192, 256};
#ifndef DIS_DFT
                    pg8::gemm_phase(lds3, gm, S, E);
#endif
                }
                volatile LAS int* sitem = (volatile LAS int*)(lds3 + 131072);
                const int myx = (int)(xb_xcc_id() & 7u);
                for (int xo = 0; xo < 8; ++xo) {
                    const int xq = (myx + xo) & 7;
                    unsigned* ctr = (unsigned*)(ws + OFF_CTL) + 4096 + 64 * ((rep * 2 + l) * 8 + xq);
                    for (;;) {
                        __syncthreads();
                        if (tid_now() == 0) *sitem = (int)atomicAdd(ctr, 1u);
                        __syncthreads();
                        const int i = *sitem;
                        if (i >= 64 || (rep == 1 && (pmx & 128))) break;
                        const int item = i < 32 ? 32 * xq + i : 256 + 32 * xq + (i - 32);
#ifndef DIS_ATT
                        attn_item(item, l, lds3);
#endif
                    }
                }
            } else if (k == 6) row_phase(l, 1, 1.0f, l, 2);
            else if (k == 9) row_phase(l, 2, 0.5f, l + 1 < 2 ? l + 1 : -1, 0);
        }
        if (again || ph + 1 < ph_hi) {
            if (ph == 0 && rep == 0) { cg::this_grid().sync();
                if (tid_now() == 0) (void)xb_add(&((unsigned*)(kws() + OFF_CTL))[XB_XCNT(xb_xcc_id())], 1u); }
            else xcd_barrier((unsigned*)(kws() + OFF_CTL), (volatile LAS unsigned*)(lds3 + 131072 + 64));
        }
        if (again) rep = 1; else { rep = 0; ++ph; }
    }
}

extern "C" void kernel_launch(void* const* d_in, const int* in_sizes, int n_in, void* d_out, int out_size, void* d_ws, size_t ws_size, hipStream_t stream) {
    static int grid = 0;
    if (grid == 0) {
        if (ws_size < WS_END) { fprintf(stderr, "kernel_launch: workspace too small: %zu < %zu\n", ws_size, (size_t)WS_END); grid = -1; return; }
        if (hipFuncSetAttribute((const void*)fwd_megakernel, hipFuncAttributeMaxDynamicSharedMemorySize, LDS_BYTES) != hipSuccess) { fprintf(stderr, "kernel_launch: hipFuncSetAttribute failed\n"); grid = -1; return; }
        int dev = 0, cus = 0, per_cu = 0;
        hipGetDevice(&dev); hipDeviceGetAttribute(&cus, hipDeviceAttributeMultiprocessorCount, dev);
        hipOccupancyMaxActiveBlocksPerMultiprocessor(&per_cu, (const void*)fwd_megakernel, 512, LDS_BYTES);
        if (per_cu < 1) { fprintf(stderr, "kernel_launch: occupancy query says %d blocks per CU\n", per_cu); per_cu = 1; }
        (void)hipGetLastError();
        grid = cus;
    }
    if (grid < 0) return;
    Params p{};
    for (int i = 0; i < 16; ++i) p.in[i] = (const float*)d_in[i];
    p.out = (float*)d_out; p.ws = (unsigned char*)d_ws; p.probe = PROBE_MASK;
#if MK_PER_PHASE
    for (int ph = 0; ph < NPHASE; ++ph) { p.ph_lo = ph; p.ph_hi = ph + 1; hipLaunchKernelGGL(fwd_megakernel, dim3(grid), dim3(512), LDS_BYTES, stream, p); }
#else
    p.ph_lo = 0; p.ph_hi = NPHASE;
    void* args[] = {&p};
    hipError_t e = hipLaunchCooperativeKernel((const void*)fwd_megakernel, dim3(grid), dim3(512), args, LDS_BYTES, stream);
    if (e != hipSuccess) fprintf(stderr, "cooperative launch failed: %s (grid %d)\n", hipGetErrorString(e), grid);
#endif
}
```

```cpp
#include <hip/hip_runtime.h>
#include <hip/hip_cooperative_groups.h>
#include <cstdio>
namespace cg = cooperative_groups;

#ifndef MK_PER_PHASE
#define MK_PER_PHASE 0
#endif

#ifndef PROBE_MASK
#define PROBE_MASK 0
#endif
#define LAS __attribute__((address_space(3)))
typedef unsigned short bf16_t;
typedef short bf16x8 __attribute__((ext_vector_type(8)));
typedef short bf16x4 __attribute__((ext_vector_type(4)));
typedef float f32x4 __attribute__((ext_vector_type(4)));
typedef unsigned u32x2 __attribute__((ext_vector_type(2)));
typedef unsigned u32x4 __attribute__((ext_vector_type(4)));

constexpr int DM = 1024, NTOK = 16384, NCTX = 8192, DFF = 2816, NIN = 2816;
constexpr int LDS_BYTES = 131072 + 1024;
constexpr int NPHASE = 22;

constexpr size_t SZ_WGU = (size_t)5632 * 1024 * 2, SZ_WDN = (size_t)1024 * 2816 * 2, SZ_WIN = (size_t)2816 * 1024 * 2, SZ_WOUT = (size_t)1024 * 1280 * 2;
constexpr size_t OFF_WGU = 0;
constexpr size_t OFF_WDN = OFF_WGU + 4 * SZ_WGU;
constexpr size_t OFF_WIN = OFF_WDN + 4 * SZ_WDN;
constexpr size_t OFF_WOUT = OFF_WIN + 2 * SZ_WIN;
constexpr size_t OFF_DLAT = OFF_WOUT + 2 * SZ_WOUT;
constexpr size_t OFF_DCTX = OFF_DLAT + (size_t)2048 * 4096 * 2;
constexpr size_t OFF_MOD = OFF_DCTX + (size_t)256 * 512 * 2;
constexpr size_t OFF_ROPE = OFF_MOD + (size_t)2 * 5 * 9216 * 4;
constexpr size_t OFF_MISC = OFF_ROPE + 8192;
constexpr size_t OFF_CTL = OFF_MISC + 1024;
constexpr size_t CTL_BYTES = 32768;
constexpr size_t OFF_H = OFF_CTL + CTL_BYTES;
constexpr size_t OFF_Y = OFF_H;
constexpr size_t OFF_XB = OFF_H + (size_t)NTOK * 1024 * 2;
constexpr size_t OFF_U = OFF_XB + (size_t)NTOK * 1024 * 2;
constexpr size_t OFF_ACT = OFF_U;
constexpr size_t OFF_Q = OFF_U;
constexpr size_t OFF_KC = OFF_Q + (size_t)NTOK * 512 * 2;
constexpr size_t OFF_VTC = OFF_KC + (size_t)32 * 4 * 256 * 128 * 2;
constexpr size_t OFF_KL = OFF_VTC + (size_t)32 * 4 * 128 * 256 * 2;
constexpr size_t OFF_VTL = OFF_KL + (size_t)4 * 4 * 2560 * 128 * 2;
constexpr size_t OFF_CONV = OFF_VTL + (size_t)4 * 4 * 128 * 2560 * 2;
constexpr size_t OFF_FTL = OFF_CONV + (size_t)3 * NTOK * 256 * 2;
constexpr size_t OFF_FTC = OFF_FTL + (size_t)1024 * 4096 * 2;
constexpr size_t END_MIX = OFF_FTC + (size_t)8192 * 512 * 2;
constexpr size_t END_ACT = OFF_ACT + (size_t)NTOK * DFF * 2;
constexpr size_t OFF_CAT = END_MIX;
constexpr size_t END_CAT = OFF_CAT + (size_t)NTOK * 1280 * 2;
constexpr size_t WS_END = END_CAT > END_ACT ? END_CAT : END_ACT;

struct Params {
    const float* in[16];
    float* out;
    unsigned char* ws;
    int ph_lo, ph_hi, probe, pad;
};

#define AS1 __attribute__((address_space(1)))
#define AS4 __attribute__((address_space(4)))
template <class T> __device__ __forceinline__ T* as_global(T* p) { return (T*)(AS1 T*)p; }
#if defined(__HIP_DEVICE_COMPILE__)
__device__ __forceinline__ const AS4 Params* kp4() { const AS4 Params* kp = (const AS4 Params*)__builtin_amdgcn_kernarg_segment_ptr(); asm volatile("" : "+s"(kp)); return kp; }
#else
__device__ const AS4 Params* kp4();
#endif
__device__ __forceinline__ const float* kin(int i) { return as_global(kp4()->in[i]); }
__device__ __forceinline__ float* kout() { return as_global(kp4()->out); }
__device__ __forceinline__ unsigned char* kws() { return as_global(kp4()->ws); }
__device__ __forceinline__ int tid_now() { int t = threadIdx.x; asm volatile("" : "+v"(t)); return t; }
__device__ __forceinline__ int permk(int key) { return (key & ~31) | (((key >> 2) & 3) << 3) | (((key >> 4) & 1) << 2) | (key & 3); }
__device__ __forceinline__ unsigned pack_bf16_t(float lo, float hi) { unsigned r; asm("s_nop 0\n\tv_cvt_pk_bf16_f32 %0, %1, %2" : "=v"(r) : "v"(lo), "v"(hi)); return r; }
__device__ __forceinline__ unsigned pack_bf16(float lo, float hi) { unsigned r; asm("v_cvt_pk_bf16_f32 %0, %1, %2" : "=v"(r) : "v"(lo), "v"(hi)); return r; }
__device__ __forceinline__ float bf_lo(unsigned u) { return __uint_as_float(u << 16); }
__device__ __forceinline__ float bf_hi(unsigned u) { return __uint_as_float(u & 0xffff0000u); }
__device__ __forceinline__ float shflx(float v, int mask, int lane) { return __int_as_float(__builtin_amdgcn_ds_bpermute((lane ^ mask) << 2, __float_as_int(v))); }
template <int CTRL> __device__ __forceinline__ float dppf(float v) { return __int_as_float(__builtin_amdgcn_update_dpp(0, __float_as_int(v), CTRL, 0xF, 0xF, true)); }
__device__ __forceinline__ float wave_sum(float v, int lane) {
    v += dppf<0xB1>(v); v += dppf<0x4E>(v); v += dppf<0x141>(v); v += dppf<0x140>(v);
    const float s0 = __int_as_float(__builtin_amdgcn_readlane(__float_as_int(v), 0)), s1 = __int_as_float(__builtin_amdgcn_readlane(__float_as_int(v), 16));
    const float s2 = __int_as_float(__builtin_amdgcn_readlane(__float_as_int(v), 32)), s3 = __int_as_float(__builtin_amdgcn_readlane(__float_as_int(v), 48));
    (void)lane; return (s0 + s1) + (s2 + s3);
}

namespace pg8 {
constexpr int BM = 256, BK = 64, HALF = 128, HTB = HALF * BK * 2, STAGE_BYTES = 8 * HTB, NXCD = 8, WGM = 8;
__device__ __forceinline__ int lds_byte(int r, int c) { const int st = (r >> 4) * 2 + (c >> 5), rr = r & 15, cc = c & 31, ob = rr * 64 + cc * 2; return st * 1024 + (ob ^ (((ob >> 9) & 1) << 5)); }
__device__ __forceinline__ void stage_rc(int b, int& R, int& C) { const int st = b / 1024, sb = b % 1024, swz = sb ^ (((sb >> 9) & 1) << 5); R = (st >> 1) * 16 + swz / 64; C = (st & 1) * 32 + (swz % 64) / 2; }
struct Unit { int pm, pn; };
struct Gemm { const bf16_t* A; const bf16_t* Bt; int M, N, K; };
struct StaticOrder {
    int nM, nN, nwg, G, c;
    __device__ void init(int M, int N, int G_, int c_) { nM = M / BM; nN = N / BM; nwg = nM * nN; G = G_; c = c_; }
    __device__ bool next(int i, Unit& u) const {
        const long L = (long)i * G + c; if (L >= nwg) return false;
        int wgid = (int)L; { const int q = nwg / NXCD, r = nwg % NXCD, xcd = wgid % NXCD, off = wgid / NXCD; wgid = (xcd < r ? xcd * (q + 1) : r * (q + 1) + (xcd - r) * q) + off; }
        const int nig = WGM * nN, gid = wgid / nig, fm = gid * WGM, gsz = (nM - fm) < WGM ? (nM - fm) : WGM;
        u.pm = fm + ((wgid % nig) % gsz); u.pn = (wgid % nig) / gsz; return true;
    }
    __device__ __forceinline__ void a_ready(const Unit&) const {}
    __device__ __forceinline__ void done(const Unit&) const {}
};
struct OneUnit {
    int valid, pm, pn;
    __device__ bool next(int i, Unit& u) const { if (i != 0 || !valid) return false; u.pm = pm; u.pn = pn; return true; }
    __device__ __forceinline__ void a_ready(const Unit&) const {}
    __device__ __forceinline__ void done(const Unit&) const {}
};

template <class Epi, class Sched>
__device__ __forceinline__ void gemm_phase(LAS unsigned char* lds, const Gemm g, const Sched& S, const Epi& E) {
    const int tid = tid_now(), wid = __builtin_amdgcn_readfirstlane(tid >> 6), lane = tid & 63, wr = wid >> 2, wc = wid & 3, fr = lane & 15, fq = lane >> 4;
    const int K = g.K, nt = K / BK;
    unsigned voffA[2], voffB[2];
#pragma unroll
    for (int i = 0; i < 2; ++i) { int R, C; stage_rc(tid * 16 + i * 8192, R, C); voffA[i] = (unsigned)(R * K + C) * 2u; voffB[i] = voffA[i]; }
    const size_t kstep = (size_t)(BK * 2);
    const size_t hstep = (size_t)HALF * K * 2;
    const size_t tstep = 2 * hstep;
    const unsigned ldsw = (unsigned)wid * 1024u;
    const int aoff = lds_byte(wr * 64 + fr, fq * 8), boff = lds_byte(wc * 32 + fr, fq * 8);
#define PG8_SA(b, h) (((b) * 2 + (h)) * HTB)
#define PG8_SB(b, h) ((4 + (b) * 2 + (h)) * HTB)
#define PG8_STAGE(bufoff, gbase, voff) do { _Pragma("unroll") for (int _i = 0; _i < 2; ++_i) \
        __builtin_amdgcn_global_load_lds((const unsigned*)((const char*)(gbase) + (voff)[_i]), (LAS unsigned*)(lds + (bufoff) + ldsw + _i * 8192), 16, 0, 0); } while (0)
#define PG8_LDA(dst, b, h) do { _Pragma("unroll") for (int m = 0; m < 4; ++m) _Pragma("unroll") for (int k = 0; k < 2; ++k) dst[m][k] = *(const LAS bf16x8*)(lds + PG8_SA(b, h) + aoff + m * 2048 + k * 1024); } while (0)
#define PG8_LDB(dst, b, h) do { _Pragma("unroll") for (int n = 0; n < 2; ++n) _Pragma("unroll") for (int k = 0; k < 2; ++k) dst[n][k] = *(const LAS bf16x8*)(lds + PG8_SB(b, h) + boff + n * 2048 + k * 1024); } while (0)
#define PG8_MMA(ai, bj, At, Bt) do { __builtin_amdgcn_s_setprio(1); _Pragma("unroll") for (int m = 0; m < 4; ++m) _Pragma("unroll") for (int n = 0; n < 2; ++n) _Pragma("unroll") for (int k = 0; k < 2; ++k) \
        acc[ai][bj][m][n] = __builtin_amdgcn_mfma_f32_16x16x32_bf16(Bt[n][k], At[m][k], acc[ai][bj][m][n], 0, 0, 0); __builtin_amdgcn_s_setprio(0); } while (0)
#define PG8_WAIT_V(n) asm volatile("s_waitcnt vmcnt(" #n ")" ::: "memory")
#define PG8_WAIT_L(n) asm volatile("s_waitcnt lgkmcnt(" #n ")" ::: "memory")
#define PG8_BAR __builtin_amdgcn_s_barrier()
#define PG8_SCHED __builtin_amdgcn_sched_barrier(0)
    Unit cur, nxt; int ui = 0;
    if (!S.next(0, cur)) return;
    f32x4 acc[2][2][4][2];
#pragma unroll
    for (int a = 0; a < 2; ++a)
#pragma unroll
        for (int b = 0; b < 2; ++b)
#pragma unroll
            for (int m = 0; m < 4; ++m)
#pragma unroll
                for (int n = 0; n < 2; ++n) acc[a][b][m][n] = (f32x4){0.f, 0.f, 0.f, 0.f};
    bf16x8 At[4][2], B0[2][2], B1[2][2];
    const char* cA = (const char*)g.A + (size_t)cur.pm * tstep; const char* cB = (const char*)g.Bt + (size_t)cur.pn * tstep;
    S.a_ready(cur);
    PG8_STAGE(PG8_SB(0, 0), cB, voffB); PG8_STAGE(PG8_SA(0, 0), cA, voffA); PG8_STAGE(PG8_SB(0, 1), cB + hstep, voffB); PG8_STAGE(PG8_SA(0, 1), cA + hstep, voffA);
    if (wr == 1) PG8_BAR;
    PG8_WAIT_V(4); PG8_BAR;
    PG8_STAGE(PG8_SB(1, 0), cB + kstep, voffB); PG8_STAGE(PG8_SA(1, 0), cA + kstep, voffA); PG8_STAGE(PG8_SB(1, 1), cB + hstep + kstep, voffB);
    PG8_WAIT_V(6); PG8_BAR;
    for (;;) {
        const bool has_next = S.next(ui + 1, nxt);
        const char* nA = has_next ? (const char*)g.A + (size_t)nxt.pm * tstep : cA; const char* nB = has_next ? (const char*)g.Bt + (size_t)nxt.pn * tstep : cB;
        for (int t = 0; t < nt; t += 2) {
            const bool last = (t == nt - 2);
            const char* a1 = cA + (size_t)(t + 1) * kstep;
            const char* a2 = last ? nA : cA + (size_t)(t + 2) * kstep; const char* b2 = last ? nB : cB + (size_t)(t + 2) * kstep;
            const char* a3 = a2 + kstep; const char* b3 = b2 + kstep;
            if (last && has_next) S.a_ready(nxt);
            PG8_LDB(B0, 0, 0); PG8_SCHED; PG8_LDA(At, 0, 0); PG8_STAGE(PG8_SA(1, 1), a1 + hstep, voffA);
            PG8_WAIT_L(8); PG8_BAR; PG8_WAIT_L(0); PG8_MMA(0, 0, At, B0); PG8_BAR; PG8_SCHED;
            PG8_LDB(B1, 0, 1); PG8_STAGE(PG8_SB(0, 0), b2, voffB);
            PG8_BAR; PG8_WAIT_L(0); PG8_MMA(0, 1, At, B1); PG8_BAR;
            PG8_LDA(At, 0, 1); PG8_STAGE(PG8_SA(0, 0), a2, voffA);
            PG8_BAR; PG8_WAIT_L(0); PG8_MMA(1, 0, At, B0); PG8_BAR; PG8_SCHED;
            PG8_STAGE(PG8_SB(0, 1), b2 + hstep, voffB);
            PG8_WAIT_V(6); PG8_BAR; PG8_MMA(1, 1, At, B1); PG8_BAR;
            PG8_LDB(B0, 1, 0); PG8_SCHED; PG8_LDA(At, 1, 0); PG8_STAGE(PG8_SA(0, 1), a2 + hstep, voffA);
            PG8_WAIT_L(8); PG8_BAR; PG8_WAIT_L(0); PG8_MMA(0, 0, At, B0); PG8_BAR; PG8_SCHED;
            PG8_LDB(B1, 1, 1); PG8_STAGE(PG8_SB(1, 0), b3, voffB);
            PG8_BAR; PG8_WAIT_L(0); PG8_MMA(0, 1, At, B1); PG8_BAR;
            PG8_LDA(At, 1, 1); PG8_STAGE(PG8_SA(1, 0), a3, voffA);
            PG8_BAR; PG8_WAIT_L(0); PG8_MMA(1, 0, At, B0); PG8_BAR; PG8_SCHED;
            PG8_STAGE(PG8_SB(1, 1), b3 + hstep, voffB);
            PG8_WAIT_V(6); PG8_BAR; PG8_MMA(1, 1, At, B1); PG8_BAR;
        }
        { const int tl = tid_now(); const int ew = __builtin_amdgcn_readfirstlane(tl >> 6), el = tl & 63;
          E(acc, cur, ew >> 2, ew & 3, el & 15, el >> 4); } S.done(cur);
        if (!has_next) break;
#pragma unroll
        for (int a = 0; a < 2; ++a)
#pragma unroll
            for (int b = 0; b < 2; ++b)
#pragma unroll
                for (int m = 0; m < 4; ++m)
#pragma unroll
                    for (int n = 0; n < 2; ++n) acc[a][b][m][n] = (f32x4){0.f, 0.f, 0.f, 0.f};
        cur = nxt; cA = nA; cB = nB; ++ui;
    }
    PG8_WAIT_V(0);
    if (wr == 0) PG8_BAR;
    PG8_BAR;
#undef PG8_SA
#undef PG8_SB
#undef PG8_STAGE
#undef PG8_LDA
#undef PG8_LDB
#undef PG8_MMA
#undef PG8_WAIT_V
#undef PG8_WAIT_L
#undef PG8_BAR
#undef PG8_SCHED
}
}
using pg8::Unit;


struct EpiSwiglu {
    int dummy;
    __device__ __forceinline__ void operator()(const f32x4 (&acc)[2][2][4][2], const Unit& u, int wr, int wc, int fr, int fq) const {
        bf16_t* O = (bf16_t*)(kws() + OFF_ACT);
        const int row0 = u.pm * 256 + wr * 64 + fr, hid = 128 * u.pn + 32 * wc + 8 * fq;
#pragma unroll
        for (int ai = 0; ai < 2; ++ai)
#pragma unroll
            for (int m = 0; m < 4; ++m) {
                u32x4 pk;
#pragma unroll
                for (int bj = 0; bj < 2; ++bj) {
                    const f32x4 g = acc[ai][bj][m][0], uu = acc[ai][bj][m][1];
                    float o[4];
#pragma unroll
                    for (int j = 0; j < 4; ++j) o[j] = g[j] * __builtin_amdgcn_rcpf(1.f + __expf(-g[j])) * uu[j];
                    if (bj == 0) { pk.x = pack_bf16(o[0], o[1]); pk.y = pack_bf16(o[2], o[3]); } else { pk.z = pack_bf16(o[0], o[1]); pk.w = pack_bf16(o[2], o[3]); }
                }
                *(u32x4*)(O + (size_t)(row0 + ai * 128 + m * 16) * DFF + hid) = pk;
            }
    }
};
struct EpiY {
    int ldc;
    __device__ __forceinline__ void operator()(const f32x4 (&acc)[2][2][4][2], const Unit& u, int wr, int wc, int fr, int fq) const {
        bf16_t* O = (bf16_t*)(kws() + OFF_Y);
        const int row0 = u.pm * 256 + wr * 64 + fr, col0 = u.pn * 256 + wc * 32 + 8 * fq;
#pragma unroll
        for (int ai = 0; ai < 2; ++ai)
#pragma unroll
            for (int m = 0; m < 4; ++m) {
                bf16_t* rowp = O + (size_t)(row0 + ai * 128 + m * 16) * ldc + col0;
#pragma unroll
                for (int bj = 0; bj < 2; ++bj) {
                    const f32x4 v0 = acc[ai][bj][m][0], v1 = acc[ai][bj][m][1];
                    u32x4 pk; pk.x = pack_bf16(v0[0], v0[1]); pk.y = pack_bf16(v0[2], v0[3]); pk.z = pack_bf16(v1[0], v1[1]); pk.w = pack_bf16(v1[2], v1[3]);
                    *(u32x4*)(rowp + bj * 128) = pk;
                }
            }
    }
};
struct EpiDft {
    int tokbase, seqlen, coloff;
    __device__ __forceinline__ void operator()(const f32x4 (&acc)[2][2][4][2], const Unit& u, int wr, int wc, int fr, int fq) const {
        bf16_t* CAT = (bf16_t*)(kws() + OFF_CAT);
        const int row0 = u.pm * 256 + wr * 64 + fr; const int b = u.pn;
        const int col0 = wc * 32 + 4 * fq;
#pragma unroll
        for (int ai = 0; ai < 2; ++ai)
#pragma unroll
            for (int m = 0; m < 4; ++m) {
                bf16_t* rowp = CAT + (size_t)(tokbase + b * seqlen + row0 + ai * 128 + m * 16) * 1280 + coloff + col0;
#pragma unroll
                for (int bj = 0; bj < 2; ++bj)
#pragma unroll
                    for (int n = 0; n < 2; ++n) {
                        const f32x4 v = acc[ai][bj][m][n];
                        u32x2 pk; pk.x = pack_bf16(v[0], v[1]); pk.y = pack_bf16(v[2], v[3]);
                        *(u32x2*)(rowp + bj * 128 + n * 16) = pk;
                    }
            }
    }
};
struct EpiIn {
    int layer;
    __device__ __forceinline__ void operator()(const f32x4 (&acc)[2][2][4][2], const Unit& u, int wr, int wc, int fr, int fq) const {
        unsigned char* ws = kws(); float* outk = kout() + (size_t)2 * NCTX * 1024; float* outv = outk + (size_t)NCTX * 1024;
        const float* ropec = (const float*)(ws + OFF_ROPE); const float* ropes = ropec + 1024;
        const int pn = u.pn; const bool lat = u.pm >= 32;
        const int row0 = u.pm * 256 + wr * 64 + fr;
        if (pn < 4) {
            const bool isq = pn < 2; const int axis = wc & 1; const int mm = wc >> 1;
            const float qs = isq ? 0.125f * 1.44269504089f : 1.0f;
#pragma unroll
            for (int ai = 0; ai < 2; ++ai)
#pragma unroll
                for (int m = 0; m < 4; ++m) { __builtin_amdgcn_sched_barrier(0);
                    const int r = row0 + ai * 128 + m * 16;
                    f32x4 cs = (f32x4){1.f, 1.f, 1.f, 1.f}, sn = (f32x4){0.f, 0.f, 0.f, 0.f};
                    int b, s;
                    if (lat) { const int t = (r - NCTX) & 2047; b = (r - NCTX) >> 11; s = t; const int pos = axis ? (t & 63) : (t >> 6);
                        cs = *(const f32x4*)(ropec + pos * 16 + 4 * fq); sn = *(const f32x4*)(ropes + pos * 16 + 4 * fq); }
                    else { b = r >> 8; s = r & 255; }
#pragma unroll
                    for (int bj = 0; bj < 2; ++bj) {
                        const int h = 2 * (pn & 1) + bj;
                        const f32x4 x1 = acc[ai][bj][m][0], x2 = acc[ai][bj][m][1];
                        f32x4 y1, y2;
#pragma unroll
                        for (int j = 0; j < 4; ++j) { y1[j] = (x1[j] * cs[j] - x2[j] * sn[j]) * qs; y2[j] = (x2[j] * cs[j] + x1[j] * sn[j]) * qs; }
                        const int cc = mm * 64 + axis * 32 + 4 * fq;
                        u32x2 p1, p2; p1.x = pack_bf16(y1[0], y1[1]); p1.y = pack_bf16(y1[2], y1[3]); p2.x = pack_bf16(y2[0], y2[1]); p2.y = pack_bf16(y2[2], y2[3]);
                        if (isq) {
                            bf16_t* qp = (bf16_t*)(ws + OFF_Q) + (size_t)r * 512 + h * 128 + cc;
                            *(u32x2*)qp = p1; *(u32x2*)(qp + 16) = p2;
                        } else {
                            bf16_t* kp = lat ? (bf16_t*)(ws + OFF_KL) + ((size_t)(b * 4 + h) * 2560 + s) * 128 + cc
                                             : (bf16_t*)(ws + OFF_KC) + ((size_t)(b * 4 + h) * 256 + s) * 128 + cc;
                            *(u32x2*)kp = p1; *(u32x2*)(kp + 16) = p2;
                            if (!lat) { float* ok = outk + ((size_t)(b * 2 + layer) * 256 + s) * 512 + h * 128 + cc; *(f32x4*)ok = x1; *(f32x4*)(ok + 16) = x2; }
                        }
                    }
                }
        } else if (pn < 6) {
#pragma unroll
            for (int ai = 0; ai < 2; ++ai)
#pragma unroll
                for (int m = 0; m < 4; ++m) { __builtin_amdgcn_sched_barrier(0);
                    const int r = row0 + ai * 128 + m * 16;
                    int b, s; if (lat) { b = (r - NCTX) >> 11; s = (r - NCTX) & 2047; } else { b = r >> 8; s = r & 255; }
#pragma unroll
                    for (int bj = 0; bj < 2; ++bj) {
                        const int h = 2 * (pn & 1) + bj;
#pragma unroll
                        for (int n = 0; n < 2; ++n) {
                            const f32x4 v = acc[ai][bj][m][n]; const int e = wc * 32 + n * 16 + 4 * fq;
                            bf16_t* vp = lat ? (bf16_t*)(ws + OFF_VTL) + ((size_t)(b * 4 + h) * 128 + e) * 2560 + permk(s)
                                             : (bf16_t*)(ws + OFF_VTC) + ((size_t)(b * 4 + h) * 128 + e) * 256 + permk(s);
                            const int ldv = lat ? 2560 : 256;
                            const unsigned p01 = pack_bf16(v[0], v[1]), p23 = pack_bf16(v[2], v[3]);
                            {
                                const int odd = fr & 1; const unsigned mine = odd ? p23 : p01, send = odd ? p01 : p23;
                                const unsigned recv = (unsigned)__builtin_amdgcn_update_dpp(0, (int)send, 0xB1, 0xF, 0xF, true);
                                const unsigned w0 = odd ? ((recv & 0xffffu) | (mine << 16)) : ((mine & 0xffffu) | (recv << 16));
                                const unsigned w1 = odd ? ((recv >> 16) | (mine & 0xffff0000u)) : ((mine >> 16) | (recv & 0xffff0000u));
                                bf16_t* vq = vp + (odd ? 2 * ldv - 1 : 0);
                                *(unsigned*)vq = w0; *(unsigned*)(vq + ldv) = w1; }
                            if (!lat) *(f32x4*)(outv + ((size_t)(b * 2 + layer) * 256 + s) * 512 + h * 128 + e) = v;
                        }
                    }
                }
        } else if (pn < 9) {
            bf16_t* base = (bf16_t*)(ws + OFF_CONV) + (size_t)(pn - 6) * NTOK * 256;
#pragma unroll
            for (int ai = 0; ai < 2; ++ai)
#pragma unroll
                for (int m = 0; m < 4; ++m) { __builtin_amdgcn_sched_barrier(0);
                    bf16_t* rowp = base + (size_t)(row0 + ai * 128 + m * 16) * 256 + wc * 32 + 8 * fq;
#pragma unroll
                    for (int bj = 0; bj < 2; ++bj) {
                        const f32x4 v0 = acc[ai][bj][m][0], v1 = acc[ai][bj][m][1];
                        u32x4 pk; pk.x = pack_bf16(v0[0], v0[1]); pk.y = pack_bf16(v0[2], v0[3]); pk.z = pack_bf16(v1[0], v1[1]); pk.w = pack_bf16(v1[2], v1[3]);
                        *(u32x4*)(rowp + bj * 128) = pk;
                    }
                }
        } else {
            const int part = pn - 9;
#pragma unroll
            for (int ai = 0; ai < 2; ++ai)
#pragma unroll
                for (int m = 0; m < 4; ++m) { __builtin_amdgcn_sched_barrier(0);
                    const int r = row0 + ai * 128 + m * 16;
                    int b, s; if (lat) { b = (r - NCTX) >> 11; s = (r - NCTX) & 2047; } else { b = r >> 8; s = r & 255; }
#pragma unroll
                    for (int bj = 0; bj < 2; ++bj)
#pragma unroll
                        for (int n = 0; n < 2; ++n) {
                            const f32x4 v = acc[ai][bj][m][n]; const int c = bj * 128 + wc * 32 + n * 16 + 4 * fq;
                            const int ldf = lat ? 2048 : 256;
                            bf16_t* fp = lat ? (bf16_t*)(ws + OFF_FTL) + (size_t)part * 1024 * 2048 + (size_t)(b * 256 + c) * 2048 + s
                                             : (bf16_t*)(ws + OFF_FTC) + (size_t)part * 8192 * 256 + (size_t)(b * 256 + c) * 256 + s;
                            const unsigned p01 = pack_bf16(v[0], v[1]), p23 = pack_bf16(v[2], v[3]);
                            {
                                const int odd = fr & 1; const unsigned mine = odd ? p23 : p01, send = odd ? p01 : p23;
                                const unsigned recv = (unsigned)__builtin_amdgcn_update_dpp(0, (int)send, 0xB1, 0xF, 0xF, true);
                                const unsigned w0 = odd ? ((recv & 0xffffu) | (mine << 16)) : ((mine & 0xffffu) | (recv << 16));
                                const unsigned w1 = odd ? ((recv >> 16) | (mine & 0xffff0000u)) : ((mine >> 16) | (recv & 0xffff0000u));
                                bf16_t* fq2 = fp + (odd ? 2 * ldf - 1 : 0);
                                *(unsigned*)fq2 = w0; *(unsigned*)(fq2 + ldf) = w1; }
                        }
                }
        }
    }
};

__device__ __forceinline__ int srccol_gu(int np) { const int pn = np >> 8, bj = (np >> 7) & 1, wc = (np >> 5) & 3, n = (np >> 4) & 1, i = np & 15;
    const int hid = 128 * pn + 32 * wc + 8 * (i >> 2) + 4 * bj + (i & 3); return n ? 2816 + hid : hid; }

__device__ __forceinline__ void xpose_tile(LAS float* tile, const float* src, int ld, int k0, int np0, int mode, int kd0, bf16_t* dst, int K) {
    const int tid = tid_now();
    { const int j4 = (tid & 63) * 4, kb = tid >> 6; const int npj = np0 + j4; const int sc = mode == 1 ? srccol_gu(npj) : (mode == 2 ? (npj & ~31) + 8 * ((npj & 15) >> 2) + 4 * ((npj >> 4) & 1) + (npj & 3) : npj);
      f32x4 v[8];
#pragma unroll
      for (int i = 0; i < 8; ++i) v[i] = *(const f32x4*)(src + (size_t)(k0 + kb + 8 * i) * ld + sc);
#pragma unroll
      for (int i = 0; i < 8; ++i) { LAS float* t = tile + (kb + 8 * i) * 257 + j4; t[0] = v[i][0]; t[1] = v[i][1]; t[2] = v[i][2]; t[3] = v[i][3]; } }
    __syncthreads();
    { const int kg = (tid & 7) * 8, nb = tid >> 3;
#pragma unroll
      for (int i = 0; i < 4; ++i) { const int n = nb + 64 * i; const LAS float* t = tile + kg * 257 + n;
          u32x4 pk; pk.x = pack_bf16(t[0], t[257]); pk.y = pack_bf16(t[2 * 257], t[3 * 257]); pk.z = pack_bf16(t[4 * 257], t[5 * 257]); pk.w = pack_bf16(t[6 * 257], t[7 * 257]);
          *(u32x4*)(dst + (size_t)(np0 + n) * K + kd0 + kg) = pk; } }
    __syncthreads();
}

__device__ __forceinline__ void prep_phase(LAS float* lds, int stage, int rank, int nblk) {
    const int tid = tid_now();
    unsigned char* ws = kws();
    constexpr int J_WGU = 4 * 16 * 22, J_WDN = 4 * 44 * 4, J_WIN = 2 * 16 * 9, J_FCS = 2 * 16 * 8, J_WOUT = 2 * 20 * 4, J_MOD = 144, J_DL = 256, J_DC = 8, J_MISC = 1;
    constexpr int E1 = J_WGU, E2 = E1 + J_WDN, E3 = E2 + J_WIN, E4 = E3 + J_FCS, E5 = E4 + J_WOUT, E6 = E5 + J_MOD, E7 = E6 + J_DL, E8 = E7 + J_DC, E9 = E8 + J_MISC;
    int s0, n0, s1, n1, s2, n2, s3, n3, s4, n4, s5, n5;
    if (stage == 0)      { s0 = E5; n0 = 72; s1 = E8; n1 = 1; s2 = 0; n2 = 0; s3 = 0; n3 = 0; s4 = 0; n4 = 0; s5 = 0; n5 = 0; }
    else if (stage == 5) { s0 = 0; n0 = 352; s1 = E5 + 72; n1 = 72; s2 = E6; n2 = E8 - E6; s3 = 0; n3 = 0; s4 = 0; n4 = 0; s5 = 0; n5 = 0; }
    else if (stage == 1) { s0 = E1; n0 = 176; s1 = E2; n1 = 144; s2 = E3; n2 = 128; s3 = 352; n3 = 352; s4 = 0; n4 = 0; s5 = 0; n5 = 0; }
    else if (stage == 2) { s0 = E1 + 176; n0 = 176; s1 = 704; n1 = 352; s2 = E2 + 144; n2 = 144; s3 = E3 + 128; n3 = 128; s4 = 0; n4 = 0; s5 = 0; n5 = 0; }
    else if (stage == 4) { s0 = 1056; n0 = 352; s1 = E1 + 528; n1 = 176; s2 = 0; n2 = 0; s3 = 0; n3 = 0; s4 = 0; n4 = 0; s5 = 0; n5 = 0; }
    else                 { s0 = E4; n0 = 160; s1 = E1 + 352; n1 = 176; s2 = 0; n2 = 0; s3 = 0; n3 = 0; s4 = 0; n4 = 0; s5 = 0; n5 = 0; }
    const int ntot = n0 + n1 + n2 + n3 + n4 + n5;
    for (int lj = rank; lj < ntot; lj += nblk) {
        int job, r = lj;
        if (r < n0) job = s0 + r; else { r -= n0;
        if (r < n1) job = s1 + r; else { r -= n1;
        if (r < n2) job = s2 + r; else { r -= n2;
        if (r < n3) job = s3 + r; else { r -= n3;
        if (r < n4) job = s4 + r; else { r -= n4; job = s5 + r; } } } } }
        if (job < E1) {
            const int mat = job / (16 * 22), r = job % (16 * 22), kt = r / 22, nt = r % 22;
            xpose_tile(lds, kin(9) + (size_t)mat * 1024 * 5632, 5632, kt * 64, nt * 256, 1, kt * 64, (bf16_t*)(ws + OFF_WGU + mat * SZ_WGU), 1024);
        } else if (job < E2) {
            const int j = job - E1; const int mat = j / (44 * 4), r = j % (44 * 4), kt = r / 4, nt = r % 4;
            xpose_tile(lds, kin(10) + (size_t)mat * 2816 * 1024, 1024, kt * 64, nt * 256, 2, kt * 64, (bf16_t*)(ws + OFF_WDN + mat * SZ_WDN), 2816);
        } else if (job < E3) {
            const int j = job - E2; const int mat = j / (16 * 9), r = j % (16 * 9), kt = r / 9, nt = r % 9;
            xpose_tile(lds, kin(11) + (size_t)mat * 1024 * 2560, 2560, kt * 64, nt * 256, nt >= 6 ? 2 : 0, kt * 64, (bf16_t*)(ws + OFF_WIN + mat * SZ_WIN), 1024);
        } else if (job < E4) {
            const int j = job - E3; const int mat = j / 128, r = j % 128, kt = r / 8, gsel = r % 8, g = gsel >> 1, sn = gsel & 1;
            const float* src = kin(11) + (size_t)mat * 1024 * 2560; const int k0 = kt * 64;
            LAS float* tile = lds; LAS float* tw = lds + 64 * 65;
            { const int jj = tid & 63, kb = tid >> 6;
#pragma unroll
              for (int i = 0; i < 8; ++i) { const int kk = kb + 8 * i; tile[kk * 65 + jj] = src[(size_t)(k0 + kk) * 2560 + 2304 + g * 64 + jj]; } }
            if (tid < 64) tw[tid] = (sn ? sinpif((float)tid / 32.f) : cospif((float)tid / 32.f)) * 0.125f;
            __syncthreads();
            bf16_t* dst = (bf16_t*)(ws + OFF_WIN + mat * SZ_WIN);
            { const int kk2 = (tid & 31) * 2, cb = tid >> 5;
#pragma unroll 1
              for (int i = 0; i < 4; ++i) { const int cc = cb + 16 * i; float v0 = 0.f, v1 = 0.f;
#pragma unroll 4
                  for (int c2 = 0; c2 < 64; ++c2) { const float w = tw[(c2 * cc) & 63]; v0 += tile[kk2 * 65 + c2] * w; v1 += tile[(kk2 + 1) * 65 + c2] * w; }
                  *(unsigned*)(dst + (size_t)(2304 + sn * 256 + g * 64 + cc) * 1024 + k0 + kk2) = pack_bf16(v0, v1); } }
            __syncthreads();
        } else if (job < E5) {
            const int j = job - E4; const int mat = j / 80, r = j % 80, kt = r / 4, nt = r % 4;
            xpose_tile(lds, kin(12) + (size_t)mat * 1024 * 1024, 1024, kt < 16 ? kt * 64 : 768 + (kt - 16) * 64, nt * 256, 2, kt * 64, (bf16_t*)(ws + OFF_WOUT + mat * SZ_WOUT), 1280);
        } else if (job < E6) {
            const int j = job - E5; const int l = j / 72, col0 = (j % 72) * 128;
            LAS float* sl = lds;
            LAS float* red = lds + 5 * 1024;
            { float cv[10]; const float* c4p = kin(4); const float* c5p = kin(5);
#pragma unroll
              for (int q = 0; q < 10; ++q) { const int i = tid + 512 * q, v = i >> 10, k = i & 1023; cv[q] = v == 0 ? c5p[k] : c4p[(v - 1) * 1024 + k]; }
              __builtin_amdgcn_sched_barrier(0);
#pragma unroll
              for (int q = 0; q < 10; ++q) sl[tid + 512 * q] = cv[q] / (1.f + __expf(-cv[q])); }
            __syncthreads();
            const int cgp = tid & 31, kc = tid >> 5;
            f32x4 a[5];
#pragma unroll
            for (int v = 0; v < 5; ++v) a[v] = (f32x4){0.f, 0.f, 0.f, 0.f};
            const float* wp = kin(6) + (size_t)l * 1024 * 9216 + col0 + 4 * cgp;
#pragma unroll 4
            for (int kk = 0; kk < 64; ++kk) { const int k = kc * 64 + kk; const f32x4 w = *(const f32x4*)(wp + (size_t)k * 9216);
#pragma unroll
                for (int v = 0; v < 5; ++v) { const float s = sl[v * 1024 + k]; a[v] += w * s; } }
#pragma unroll
            for (int v = 0; v < 5; ++v) *(LAS f32x4*)(red + (kc * 5 + v) * 128 + 4 * cgp) = a[v];
            __syncthreads();
            const float* bmp = kin(7);
            for (int i = tid; i < 5 * 128; i += 512) { const int v = i / 128, cc = i % 128; float s = bmp[l * 9216 + col0 + cc];
                for (int q = 0; q < 16; ++q) s += red[(q * 5 + v) * 128 + cc];
                ((float*)(ws + OFF_MOD))[(size_t)(l * 5 + v) * 9216 + col0 + cc] = s; }
            __syncthreads();
        } else if (job < E7) {
            const int j = job - E6; bf16_t* D = (bf16_t*)(ws + OFF_DLAT); const float sc = 0.02209708691f;
            LAS float* tc = lds; LAS float* tsn = lds + 2048;
#pragma unroll 1
            for (int i = tid; i < 2048; i += 512) { float sv, cv; sincospif((float)i * (1.f / 1024.f), &sv, &cv); tc[i] = cv * sc; tsn[i] = -sv * sc; }
            __syncthreads();
#pragma unroll 2
            for (int i = tid; i < 8 * 1024; i += 512) { const int np = j * 8 + (i >> 10), n = (i & 1023) * 2;
                const int m0 = (np * n) & 2047, m1 = (np * (n + 1)) & 2047;
                *(unsigned*)(D + (size_t)np * 2048 + n) = pack_bf16(tc[m0], tc[m1]);
                *(unsigned*)(D + (size_t)2048 * 2048 + (size_t)np * 2048 + n) = pack_bf16(tsn[m0], tsn[m1]); }
            __syncthreads();
        } else if (job < E8) {
            const int j = job - E7; bf16_t* D = (bf16_t*)(ws + OFF_DCTX); const float sc = 0.0625f;
#pragma unroll 1
            for (int i = tid; i < 32 * 128; i += 512) { const int np = j * 32 + (i >> 7), n = (i & 127) * 2;
                const int m0 = (np * n) & 255, m1 = (np * (n + 1)) & 255;
                float s0, c0, s1, c1; sincospif((float)m0 * (1.f / 128.f), &s0, &c0); sincospif((float)m1 * (1.f / 128.f), &s1, &c1);
                *(unsigned*)(D + (size_t)np * 256 + n) = pack_bf16(c0 * sc, c1 * sc);
                *(unsigned*)(D + (size_t)256 * 256 + (size_t)np * 256 + n) = pack_bf16(-s0 * sc, -s1 * sc); }
        } else {
            float* rc = (float*)(ws + OFF_ROPE); float* rs = rc + 1024;
#pragma unroll 1
            for (int i = tid; i < 1024; i += 512) { const int pos = i >> 4, f = i & 15; const float inv = 1.0f / powf(10000.0f, (float)f / 16.0f); const float ang = (float)pos * inv; rc[i] = cosf(ang); rs[i] = sinf(ang); }
            if (tid < 2) { const float* lq = kin(14) + tid * 256; float d0 = 0.f, d1 = 0.f; for (int i = 0; i < 64; ++i) { d0 += lq[i] * lq[64 + i]; d1 += lq[128 + i] * lq[192 + i]; }
                const float li = 0.8f - 0.6f * expf(-0.3f * (float)tid); ((float*)(ws + OFF_MISC))[tid] = expf(d0) - expf(d1) + li; ((float*)(ws + OFF_MISC))[2 + tid] = li; }
        }
    }
}

__device__ __forceinline__ void unpack8(const u32x4 a, f32x4& lo, f32x4& hi) { lo = (f32x4){bf_lo(a.x), bf_hi(a.x), bf_lo(a.y), bf_hi(a.y)}; hi = (f32x4){bf_lo(a.z), bf_hi(a.z), bf_lo(a.w), bf_hi(a.w)}; }
__device__ __forceinline__ u32x4 pack8(const f32x4 lo, const f32x4 hi) { u32x4 p; p.x = pack_bf16(lo[0], lo[1]); p.y = pack_bf16(lo[2], lo[3]); p.z = pack_bf16(hi[0], hi[1]); p.w = pack_bf16(hi[2], hi[3]); return p; }
__device__ __forceinline__ void row_phase(int lprev, int sprev, float rw, int lnext, int snext) {
    const int tid = tid_now(), wave = tid >> 6, lane = tid & 63;
    float* XO = kout(); unsigned char* ws = kws();
    const bf16_t* Y = (const bf16_t*)(ws + OFF_Y); bf16_t* H = (bf16_t*)(ws + OFF_H); bf16_t* XB = (bf16_t*)(ws + OFF_XB);
    const float* MOD = (const float*)(ws + OFF_MOD); const float* NG = kin(8);
    const float* xin0 = kin(0); const float* xin1 = kin(1);
    const int nwave = gridDim.x * 8, RW = NTOK / nwave, gw = blockIdx.x * 8 + wave;
    const int rbase = gw * RW;
    const int v = rbase < NCTX ? 0 : 1 + ((rbase - NCTX) >> 11);
    f32x4 vgate[4], vgpost[4], vsh[4], vsc[4], vgpre[4];
    if (lprev >= 0) { const float* gate = MOD + (size_t)(lprev * 5 + v) * 9216 + (3 * sprev + 2) * 1024; const float* gp = NG + (lprev * 6 + 2 * sprev + 1) * 1024;
#pragma unroll
        for (int q = 0; q < 4; ++q) { const int col = 512 * (q >> 1) + 8 * lane + 4 * (q & 1); vgate[q] = *(const f32x4*)(gate + col) * rw; vgpost[q] = *(const f32x4*)(gp + col); } }
    if (lnext >= 0) { const float* sh = MOD + (size_t)(lnext * 5 + v) * 9216 + (3 * snext) * 1024; const float* scp = sh + 1024; const float* gp = NG + (lnext * 6 + 2 * snext) * 1024;
#pragma unroll
        for (int q = 0; q < 4; ++q) { const int col = 512 * (q >> 1) + 8 * lane + 4 * (q & 1); vsh[q] = *(const f32x4*)(sh + col); vsc[q] = *(const f32x4*)(scp + col) + 1.f; vgpre[q] = *(const f32x4*)(gp + col); } }
    for (int j = 0; j < RW; j += 2) {
        int rows[2]; rows[0] = rbase + j; rows[1] = j + 1 < RW ? rbase + j + 1 : rbase + j;
        f32x4 x[2][4], y[2][4];
        u32x4 rx[2][2], ry[2][2];
#pragma unroll
        for (int u = 0; u < 2; ++u) {
            const int row = rows[u];
            if (lprev < 0) { const float* src = row < NCTX ? xin0 + (size_t)row * 1024 : xin1 + (size_t)(row - NCTX) * 1024;
#pragma unroll
                for (int q = 0; q < 4; ++q) x[u][q] = *(const f32x4*)(src + 512 * (q >> 1) + 8 * lane + 4 * (q & 1));
            } else {
#pragma unroll
                for (int i = 0; i < 2; ++i) rx[u][i] = *(const u32x4*)(XB + (size_t)row * 1024 + 512 * i + 8 * lane);
#pragma unroll
                for (int i = 0; i < 2; ++i) ry[u][i] = *(const u32x4*)(Y + (size_t)row * 1024 + 512 * i + 8 * lane);
            }
        }
        __builtin_amdgcn_sched_barrier(0);
        if (lprev >= 0) {
#pragma unroll
            for (int u = 0; u < 2; ++u)
#pragma unroll
                for (int i = 0; i < 2; ++i) { unpack8(rx[u][i], x[u][2 * i], x[u][2 * i + 1]); unpack8(ry[u][i], y[u][2 * i], y[u][2 * i + 1]); }
        }
#pragma unroll
        for (int u = 0; u < 2; ++u) {
            const int row = rows[u];
            if (lprev >= 0) {
                float ss = 0.f;
#pragma unroll
                for (int q = 0; q < 4; ++q) ss += y[u][q][0] * y[u][q][0] + y[u][q][1] * y[u][q][1] + y[u][q][2] * y[u][q][2] + y[u][q][3] * y[u][q][3];
                ss = wave_sum(ss, lane); const float r = rsqrtf(ss * (1.f / 1024.f) + 1e-6f);
#pragma unroll
                for (int q = 0; q < 4; ++q) x[u][q] += vgate[q] * (y[u][q] * r * vgpost[q]);
            }
            if (lnext < 0) {
#pragma unroll
                for (int q = 0; q < 4; ++q) *(f32x4*)(XO + (size_t)row * 1024 + 512 * (q >> 1) + 8 * lane + 4 * (q & 1)) = x[u][q];
            } else {
#pragma unroll
                for (int i = 0; i < 2; ++i) *(u32x4*)(XB + (size_t)row * 1024 + 512 * i + 8 * lane) = pack8(x[u][2 * i], x[u][2 * i + 1]);
                float ss = 0.f;
#pragma unroll
                for (int q = 0; q < 4; ++q) ss += x[u][q][0] * x[u][q][0] + x[u][q][1] * x[u][q][1] + x[u][q][2] * x[u][q][2] + x[u][q][3] * x[u][q][3];
                ss = wave_sum(ss, lane); const float r = rsqrtf(ss * (1.f / 1024.f) + 1e-6f);
                f32x4 h[4];
#pragma unroll
                for (int q = 0; q < 4; ++q) h[q] = x[u][q] * r * vgpre[q] * vsc[q] + vsh[q];
#pragma unroll
                for (int i = 0; i < 2; ++i) *(u32x4*)(H + (size_t)row * 1024 + 512 * i + 8 * lane) = pack8(h[2 * i], h[2 * i + 1]);
            }
        }
    }
}

__device__ __forceinline__ void cache_convert(int l, LAS unsigned char* lds) {
    unsigned char* ws = kws(); const int tid = tid_now(); const int gt = blockIdx.x * 512 + tid, gs = gridDim.x * 512;
    bf16_t* KL = (bf16_t*)(ws + OFF_KL); bf16_t* VTL = (bf16_t*)(ws + OFF_VTL);
    const float* ckp = kin(2); const float* cvp = kin(3);
    for (int i = gt; i < 4 * 512 * 4 * 32; i += gs) {
        const int c4 = i & 31, h = (i >> 5) & 3, s = (i >> 7) & 511, b = i >> 16;
        const f32x4 v = *(const f32x4*)(ckp + ((((size_t)b * 2 + l) * 512 + s) * 4 + h) * 128 + c4 * 4);
        u32x2 pk; pk.x = pack_bf16(v[0], v[1]); pk.y = pack_bf16(v[2], v[3]);
        *(u32x2*)(KL + ((size_t)(b * 4 + h) * 2560 + 2048 + s) * 128 + c4 * 4) = pk;
    }
    constexpr int S = 136;
    for (int job = blockIdx.x; job < 128; job += gridDim.x) {
        const int kt = job & 7, h = (job >> 3) & 3, b = job >> 5;
        const int e4 = tid & 31, kb = tid >> 5;
        __syncthreads();
        f32x4 rv[4];
#pragma unroll
        for (int i = 0; i < 4; ++i) rv[i] = *(const f32x4*)(cvp + ((((size_t)b * 2 + l) * 512 + kt * 64 + kb + 16 * i) * 4 + h) * 128 + e4 * 4);
        __builtin_amdgcn_sched_barrier(0);
#pragma unroll
        for (int i = 0; i < 4; ++i) { const int key = kb + 16 * i;
            const f32x4 v = rv[i];
            const unsigned p01 = pack_bf16(v[0], v[1]), p23 = pack_bf16(v[2], v[3]);
            LAS unsigned char* t0 = lds + (4 * e4) * S + key * 2;
            *(LAS bf16_t*)t0 = (bf16_t)(p01 & 0xffff); *(LAS bf16_t*)(t0 + S) = (bf16_t)(p01 >> 16); *(LAS bf16_t*)(t0 + 2 * S) = (bf16_t)(p23 & 0xffff); *(LAS bf16_t*)(t0 + 3 * S) = (bf16_t)(p23 >> 16); }
        __syncthreads();
        { const int e = tid >> 2, q = tid & 3; const LAS unsigned char* r = lds + e * S + q * 32;
          bf16_t* dst = VTL + ((size_t)(b * 4 + h) * 128 + e) * 2560 + 2048 + kt * 64 + 32 * (q >> 1) + 4 * (q & 1);
#pragma unroll
          for (int g = 0; g < 4; ++g) *(u32x2*)(dst + 8 * g) = *(const LAS u32x2*)(r + g * 8); }
    }
}

constexpr int KSTR = 272, VSTR = 128;
constexpr int KT_BYTES = 64 * KSTR, VT_BYTES = 128 * VSTR;

__device__ __forceinline__ void attn_item(int item, int layer, LAS unsigned char* lds) {
    const int tid = tid_now(), wave = tid >> 6, lane = tid & 63, fr = lane & 15, g = lane >> 4;
    unsigned char* ws = kws();
    const bool lat = item < 256;
    int b, h, qb; if (lat) { b = item >> 6; h = (item >> 4) & 3; qb = item & 15; } else { const int j = item - 256; b = j >> 3; h = (j >> 1) & 3; qb = j & 1; }
    const int L = lat ? 2560 : 256, seq = lat ? 2048 : 256;
    const int tokb = lat ? NCTX + b * 2048 : b * 256;
    const int tok0 = tokb + qb * 128;
    const bf16_t* Kb = lat ? (const bf16_t*)(ws + OFF_KL) + (size_t)(b * 4 + h) * 2560 * 128 : (const bf16_t*)(ws + OFF_KC) + (size_t)(b * 4 + h) * 256 * 128;
    const bf16_t* Vb = lat ? (const bf16_t*)(ws + OFF_VTL) + (size_t)(b * 4 + h) * 128 * 2560 : (const bf16_t*)(ws + OFF_VTC) + (size_t)(b * 4 + h) * 128 * 256;
    const float lam = ((const float*)(ws + OFF_MISC))[layer], lam_init = ((const float*)(ws + OFF_MISC))[2 + layer];
    bf16_t* CAT = (bf16_t*)(ws + OFF_CAT);

    {
        const bf16_t* GB = (const bf16_t*)(ws + OFF_CONV); const bf16_t* GC = GB + (size_t)NTOK * 256; const bf16_t* HC = GC + (size_t)NTOK * 256;
        const float* cw = kin(13) + layer * 768;
        const int c4 = (tid & 15) * 4 + h * 64, tb = tid >> 4;
        const f32x4 w0 = *(const f32x4*)(cw + c4), w1 = *(const f32x4*)(cw + 256 + c4), w2 = *(const f32x4*)(cw + 512 + c4);
#pragma unroll
        for (int i = 0; i < 4; ++i) {
            const int tl = qb * 128 + tb + 32 * i;
            const size_t t = (size_t)(tokb + tl);
            f32x4 um = (f32x4){0.f, 0.f, 0.f, 0.f}, up = um, u0;
            { const u32x2 a = *(const u32x2*)(GC + t * 256 + c4), c = *(const u32x2*)(HC + t * 256 + c4);
              u0 = (f32x4){bf_lo(a.x) * bf_lo(c.x), bf_hi(a.x) * bf_hi(c.x), bf_lo(a.y) * bf_lo(c.y), bf_hi(a.y) * bf_hi(c.y)}; }
            if (tl > 0) { const u32x2 a = *(const u32x2*)(GC + (t - 1) * 256 + c4), c = *(const u32x2*)(HC + (t - 1) * 256 + c4);
              um = (f32x4){bf_lo(a.x) * bf_lo(c.x), bf_hi(a.x) * bf_hi(c.x), bf_lo(a.y) * bf_lo(c.y), bf_hi(a.y) * bf_hi(c.y)}; }
            if (tl < seq - 1) { const u32x2 a = *(const u32x2*)(GC + (t + 1) * 256 + c4), c = *(const u32x2*)(HC + (t + 1) * 256 + c4);
              up = (f32x4){bf_lo(a.x) * bf_lo(c.x), bf_hi(a.x) * bf_hi(c.x), bf_lo(a.y) * bf_lo(c.y), bf_hi(a.y) * bf_hi(c.y)}; }
            const u32x2 gbu = *(const u32x2*)(GB + t * 256 + c4);
            const f32x4 gbv = (f32x4){bf_lo(gbu.x), bf_hi(gbu.x), bf_lo(gbu.y), bf_hi(gbu.y)};
            const f32x4 o = gbv * (um * w0 + u0 * w1 + up * w2);
            u32x2 pk; pk.x = pack_bf16(o[0], o[1]); pk.y = pack_bf16(o[2], o[3]);
            *(u32x2*)(CAT + t * 1280 + 512 + c4) = pk;
        }
    }

    if (wave < 4) __builtin_amdgcn_s_setprio(2); else __builtin_amdgcn_s_setprio(0);
    const int qtok = tok0 + wave * 16 + fr;
    bf16x8 qf[2][2];
#pragma unroll
    for (int m = 0; m < 2; ++m)
#pragma unroll
        for (int ks = 0; ks < 2; ++ks) qf[m][ks] = *(const bf16x8*)((const bf16_t*)(ws + OFF_Q) + (size_t)qtok * 512 + h * 128 + m * 64 + ks * 32 + g * 8);

    LAS unsigned char* Kt[2] = {lds, lds + KT_BYTES};
    LAS unsigned char* Vt[2] = {lds + 2 * KT_BYTES, lds + 2 * KT_BYTES + VT_BYTES};
    const int skey = tid >> 3, sseg = tid & 7;
    const int ve = tid >> 2, vseg = tid & 3;
    const int vsw = (ve >> 1) & 7;
    const int vw0 = ve * 128 + (((2 * vseg) ^ vsw) << 4), vw1 = ve * 128 + (((2 * vseg + 1) ^ vsw) << 4);
    const int kro = fr * KSTR + g * 16;
    const int rsw = (fr >> 1) & 7;
    const int vro0 = fr * 128 + ((g ^ rsw) << 4), vro1 = fr * 128 + (((4 + g) ^ rsw) << 4);
    const int ntile = L / 64;

#define ATT_RDK(dst, base, c2) do { _Pragma("unroll") for (int sub = 0; sub < 2; ++sub) _Pragma("unroll") for (int m = 0; m < 2; ++m) _Pragma("unroll") for (int ks = 0; ks < 2; ++ks) \
        dst[sub][m][ks] = *(const LAS bf16x8*)((base) + ((c2) * 2 + sub) * 16 * KSTR + kro + m * 128 + ks * 64); } while (0)
#define ATT_QK(sdst, kf, i0_, i1_) do { _Pragma("unroll") for (int sub = 0; sub < 2; ++sub) _Pragma("unroll") for (int m = 0; m < 2; ++m) { f32x4 a_ = m ? i1_ : i0_; \
        _Pragma("unroll") for (int ks = 0; ks < 2; ++ks) a_ = __builtin_amdgcn_mfma_f32_16x16x32_bf16(kf[sub][m][ks], qf[m][ks], a_, 0, 0, 0); sdst[m][sub] = a_; } } while (0)

    float mrun[2] = {-INFINITY, -INFINITY};
    const f32x4 zero4 = (f32x4){0.f, 0.f, 0.f, 0.f};
#define ATT_LDK(k0_, k1_, tt) do { const bf16_t* src_ = Kb + (size_t)((tt) * 64 + skey) * 128 + sseg * 16; k0_ = *(const u32x4*)src_; k1_ = *(const u32x4*)(src_ + 8); } while (0)
#define ATT_WRK(k0_, k1_, bi) do { LAS unsigned char* d_ = Kt[bi] + skey * KSTR + sseg * 32; *(LAS u32x4*)d_ = k0_; *(LAS u32x4*)(d_ + 16) = k1_; } while (0)
#define ATT_P1(bi) do { const LAS unsigned char* kt_ = Kt[bi]; \
            bf16x8 kfA[2][2][2], kfB[2][2][2]; ATT_RDK(kfA, kt_, 0); ATT_RDK(kfB, kt_, 1); __builtin_amdgcn_sched_barrier(0); \
            f32x4 sA[2][2], sB[2][2]; ATT_QK(sA, kfA, zero4, zero4); ATT_QK(sB, kfB, zero4, zero4); __builtin_amdgcn_sched_barrier(0); \
            _Pragma("unroll") for (int m = 0; m < 2; ++m) { \
                    const f32x4 v0 = sA[m][0], v1 = sA[m][1], v2 = sB[m][0], v3 = sB[m][1]; \
                    const float t0 = fmaxf(fmaxf(fmaxf(v0[0], v0[1]), fmaxf(v0[2], v0[3])), fmaxf(fmaxf(v1[0], v1[1]), fmaxf(v1[2], v1[3]))); \
                    const float t1 = fmaxf(fmaxf(fmaxf(v2[0], v2[1]), fmaxf(v2[2], v2[3])), fmaxf(fmaxf(v3[0], v3[1]), fmaxf(v3[2], v3[3]))); \
                    mrun[m] = fmaxf(mrun[m], fmaxf(t0, t1)); } } while (0)
    float bnd[2];
    {
        float km = 0.f;
        for (int t0 = 0; t0 < ntile; t0 += 4) {
            u32x4 ra[4], rb[4];
#pragma unroll
            for (int tt = 0; tt < 4; ++tt) { const bf16_t* src_ = Kb + (size_t)((t0 + tt) * 64 + skey) * 128 + sseg * 16; ra[tt] = *(const u32x4*)src_; rb[tt] = *(const u32x4*)(src_ + 8); }
            __builtin_amdgcn_sched_barrier(0);
#pragma unroll
            for (int tt = 0; tt < 4; ++tt) {
                const u32x4 a = ra[tt], b2 = rb[tt];
                float ss = 0.f;
                { const unsigned w[8] = {a.x, a.y, a.z, a.w, b2.x, b2.y, b2.z, b2.w};
#pragma unroll
                  for (int i = 0; i < 8; ++i) { const float lo = bf_lo(w[i]), hi = bf_hi(w[i]); ss += lo * lo + hi * hi; } }
                ss += dppf<0xB1>(ss); ss += dppf<0x4E>(ss);
                km = fmaxf(km, ss);
            }
        }
        km = fmaxf(km, shflx(km, 8, lane)); km = fmaxf(km, shflx(km, 16, lane)); km = fmaxf(km, shflx(km, 32, lane));
        volatile LAS float* red = (volatile LAS float*)(lds + 100000);
        __syncthreads();
        if ((lane & 59) == 0) red[wave * 2 + (lane >> 2)] = km;
        __syncthreads();
        float k2[2];
#pragma unroll
        for (int m = 0; m < 2; ++m) { float v = red[m]; for (int w = 1; w < 8; ++w) v = fmaxf(v, red[w * 2 + m]); k2[m] = v; }
        float bw = 0.f;
#pragma unroll
        for (int m = 0; m < 2; ++m) {
            float q2 = 0.f;
#pragma unroll
            for (int ks = 0; ks < 2; ++ks) { u32x4 u; __builtin_memcpy(&u, &qf[m][ks], 16); const unsigned w[4] = {u.x, u.y, u.z, u.w};
#pragma unroll
                for (int i = 0; i < 4; ++i) { const float lo = bf_lo(w[i]), hi = bf_hi(w[i]); q2 += lo * lo + hi * hi; } }
            q2 += shflx(q2, 16, lane); q2 += shflx(q2, 32, lane);
            bnd[m] = sqrtf(q2 * k2[m]) * 1.001f + 1e-3f; bw = fmaxf(bw, bnd[m]);
        }
        bw = fmaxf(bw, shflx(bw, 1, lane)); bw = fmaxf(bw, shflx(bw, 2, lane)); bw = fmaxf(bw, shflx(bw, 4, lane)); bw = fmaxf(bw, shflx(bw, 8, lane));
        __syncthreads();
        if (lane == 0) red[16 + wave] = bw;
        __syncthreads();
        float ball = red[16]; for (int w = 1; w < 8; ++w) ball = fmaxf(ball, red[16 + w]);
        bnd[0] = (ball > 60.f || (kp4()->probe & 256)) ? -1.f : bnd[0];
    }
    const bool exact = bnd[0] < 0.f;
    if (exact) {
        mrun[0] = mrun[1] = -INFINITY;
        u32x4 ka0, ka1;
        ATT_LDK(ka0, ka1, 0); ATT_WRK(ka0, ka1, 0);
        __syncthreads();
        for (int t = 0; t < ntile; ++t) {
            if (t + 1 < ntile) ATT_LDK(ka0, ka1, t + 1);
            ATT_P1(t & 1);
            if (t + 1 < ntile) ATT_WRK(ka0, ka1, (t + 1) & 1);
            __syncthreads();
        }
    }
    f32x4 negM[2];
#pragma unroll
    for (int m = 0; m < 2; ++m) { float mx = fmaxf(mrun[m], shflx(mrun[m], 16, lane)); mx = fmaxf(mx, shflx(mx, 32, lane)); if (!exact) mx = bnd[m]; negM[m] = (f32x4){-mx, -mx, -mx, -mx}; }
    f32x4 o0[8], o1[8]; float lsum[2] = {0.f, 0.f};
#pragma unroll
    for (int et = 0; et < 8; ++et) { o0[et] = zero4; o1[et] = zero4; }
#define ATT_SOFTMAX(pb0, pb1, sx) do { float e0_[8], e1_[8]; _Pragma("unroll") for (int sub = 0; sub < 2; ++sub) _Pragma("unroll") for (int j = 0; j < 4; ++j) { \
        e0_[sub * 4 + j] = __builtin_amdgcn_exp2f(sx[0][sub][j]); e1_[sub * 4 + j] = __builtin_amdgcn_exp2f(sx[1][sub][j]); } \
        lsum[0] += ((e0_[0] + e0_[1]) + (e0_[2] + e0_[3])) + ((e0_[4] + e0_[5]) + (e0_[6] + e0_[7])); lsum[1] += ((e1_[0] + e1_[1]) + (e1_[2] + e1_[3])) + ((e1_[4] + e1_[5]) + (e1_[6] + e1_[7])); \
        u32x4 pk_; pk_.x = pack_bf16_t(e0_[0], e0_[1]); pk_.y = pack_bf16_t(e0_[2], e0_[3]); pk_.z = pack_bf16_t(e0_[4], e0_[5]); pk_.w = pack_bf16_t(e0_[6], e0_[7]); __builtin_memcpy(&pb0, &pk_, 16); \
        pk_.x = pack_bf16_t(e1_[0], e1_[1]); pk_.y = pack_bf16_t(e1_[2], e1_[3]); pk_.z = pack_bf16_t(e1_[4], e1_[5]); pk_.w = pack_bf16_t(e1_[6], e1_[7]); __builtin_memcpy(&pb1, &pk_, 16); } while (0)
#define ATT_LDV(v0_, v1_, tt) do { const bf16_t* vs_ = Vb + (size_t)ve * L + (tt) * 64 + vseg * 16; v0_ = *(const u32x4*)vs_; v1_ = *(const u32x4*)(vs_ + 8); } while (0)
#define ATT_WRV(v0_, v1_, bi) do { *(LAS u32x4*)(Vt[bi] + vw0) = v0_; *(LAS u32x4*)(Vt[bi] + vw1) = v1_; } while (0)
#define ATT_P2(bi) do { const LAS unsigned char* kt_ = Kt[bi]; const LAS unsigned char* vt_ = Vt[bi]; \
            f32x4 sA[2][2], sB[2][2]; \
            { bf16x8 kfA[2][2][2], kfB[2][2][2]; ATT_RDK(kfA, kt_, 0); ATT_RDK(kfB, kt_, 1); __builtin_amdgcn_sched_barrier(0); \
              ATT_QK(sA, kfA, negM[0], negM[1]); ATT_QK(sB, kfB, negM[0], negM[1]); } __builtin_amdgcn_sched_barrier(0); \
            bf16x8 vfA[8], vfB[8], pA0, pA1, pB0, pB1; \
            _Pragma("unroll") for (int et = 0; et < 8; ++et) vfA[et] = *(const LAS bf16x8*)(vt_ + et * 2048 + vro0); \
            ATT_SOFTMAX(pA0, pA1, sA); __builtin_amdgcn_sched_barrier(0); \
            _Pragma("unroll") for (int et = 0; et < 8; ++et) vfB[et] = *(const LAS bf16x8*)(vt_ + et * 2048 + vro1); \
            _Pragma("unroll") for (int et = 0; et < 8; ++et) { o0[et] = __builtin_amdgcn_mfma_f32_16x16x32_bf16(vfA[et], pA0, o0[et], 0, 0, 0); o1[et] = __builtin_amdgcn_mfma_f32_16x16x32_bf16(vfA[et], pA1, o1[et], 0, 0, 0); } \
            ATT_SOFTMAX(pB0, pB1, sB); __builtin_amdgcn_sched_barrier(0); \
            _Pragma("unroll") for (int et = 0; et < 8; ++et) { o0[et] = __builtin_amdgcn_mfma_f32_16x16x32_bf16(vfB[et], pB0, o0[et], 0, 0, 0); o1[et] = __builtin_amdgcn_mfma_f32_16x16x32_bf16(vfB[et], pB1, o1[et], 0, 0, 0); } } while (0)
    {
        u32x4 ka0, ka1, va0, va1;
        ATT_LDK(ka0, ka1, 0); ATT_LDV(va0, va1, 0); ATT_WRK(ka0, ka1, 0); ATT_WRV(va0, va1, 0);
        __syncthreads();
        for (int t = 0; t < ntile; ++t) {
            if (t + 1 < ntile) { ATT_LDK(ka0, ka1, t + 1); ATT_LDV(va0, va1, t + 1); }
            ATT_P2(t & 1);
            if (t + 1 < ntile) { ATT_WRK(ka0, ka1, (t + 1) & 1); ATT_WRV(va0, va1, (t + 1) & 1); }
            __syncthreads();
        }
    }
#undef ATT_LDK
#undef ATT_WRK
#undef ATT_LDV
#undef ATT_WRV
#undef ATT_P1
#undef ATT_P2
#undef ATT_RDK
#undef ATT_QK
#undef ATT_SOFTMAX
    __builtin_amdgcn_s_setprio(0);
    float c0, c1;
    { float l0 = lsum[0]; l0 += shflx(l0, 16, lane); l0 += shflx(l0, 32, lane); float l1 = lsum[1]; l1 += shflx(l1, 16, lane); l1 += shflx(l1, 32, lane); c0 = 1.f / l0; c1 = lam / l1; }
    f32x4 o[8];
#pragma unroll
    for (int et = 0; et < 8; ++et) o[et] = o0[et] * c0 - o1[et] * c1;
    float ss = 0.f;
#pragma unroll
    for (int et = 0; et < 8; ++et) ss += o[et][0] * o[et][0] + o[et][1] * o[et][1] + o[et][2] * o[et][2] + o[et][3] * o[et][3];
    ss += shflx(ss, 16, lane); ss += shflx(ss, 32, lane);
    const float r = rsqrtf(ss * (1.f / 128.f) + 1e-6f) * (1.f - lam_init);
    const float* sg = kin(15) + layer * 128;
    f32x4 ggv[8];
#pragma unroll
    for (int et = 0; et < 8; ++et) ggv[et] = *(const f32x4*)(sg + et * 16 + 4 * g);
    __builtin_amdgcn_sched_barrier(0);
#pragma unroll
    for (int et = 0; et < 8; ++et) { const f32x4 gg = ggv[et]; const f32x4 v = o[et] * r * gg;
        u32x2 pk; pk.x = pack_bf16(v[0], v[1]); pk.y = pack_bf16(v[2], v[3]);
        *(u32x2*)(CAT + (size_t)qtok * 1280 + h * 128 + et * 16 + 4 * g) = pk; }
}

#define XB_TMO      128
#define XB_XCNT(j)  (256  + 64 * (j))
#define XB_XSUB(j)  (1280 + 64 * (j))
#define XB_XGEN(j)  (2304 + 64 * (j))
#define XB_TOP      3328
#define XB_TOPGEN   3392
#define XB_SPIN_CAP (1u << 18)
__device__ __forceinline__ unsigned xb_ld(unsigned* p)              { return __hip_atomic_load(p, __ATOMIC_RELAXED, __HIP_MEMORY_SCOPE_AGENT); }
__device__ __forceinline__ unsigned xb_add(unsigned* p, unsigned v) { return __hip_atomic_fetch_add(p, v, __ATOMIC_RELAXED, __HIP_MEMORY_SCOPE_AGENT); }
__device__ __forceinline__ unsigned xb_xcc_id() { return (unsigned)__builtin_amdgcn_s_getreg((3 << 11) | 20) & 0xFu; }
#define XB_SPIN(cond, bar) do { unsigned _sp = 0; while (cond) { __builtin_amdgcn_s_sleep(6); \
    if ((++_sp & 255u) == 0u) { if (xb_ld(&(bar)[XB_TMO])) break; if (_sp > XB_SPIN_CAP) { atomicAdd(&(bar)[XB_TMO], 1u); break; } } } } while (0)
__device__ __forceinline__ void xcd_barrier_complete(unsigned* bar, unsigned x, unsigned& nloc, unsigned& nx) {
    const unsigned G = gridDim.x;
    unsigned sum, cnt, mine, sp = 0u;
    for (;;) {
        sum = 0u; cnt = 0u; mine = 0u;
#pragma unroll
        for (unsigned j = 0; j < 16; ++j) { const unsigned c = xb_ld(&bar[XB_XCNT(j)]); sum += c; cnt += (c > 0u) ? 1u : 0u; mine = (j == x) ? c : mine; }
        if (sum == G) break;
        __builtin_amdgcn_s_sleep(1);
        if ((++sp & 255u) == 0u) { if (xb_ld(&bar[XB_TMO])) break; if (sp > XB_SPIN_CAP) { atomicAdd(&bar[XB_TMO], 1u); break; } }
    }
    nloc = mine > 0u ? mine : 1u; nx = cnt > 0u ? cnt : 1u;
}
__device__ __forceinline__ void xcd_barrier(unsigned* bar, volatile LAS unsigned* st) {
    asm volatile("s_waitcnt vmcnt(0)" ::: "memory");
    __syncthreads();
    if (tid_now() == 0) {
        const unsigned x = xb_xcc_id();
        __builtin_amdgcn_s_waitcnt(0);
        unsigned nloc = st[0], nx = st[1];
        if (nloc == 0u) { xcd_barrier_complete(bar, x, nloc, nx); st[0] = nloc; st[1] = nx; }
        const unsigned old = xb_add(&bar[XB_XSUB(x)], 1u);
        const unsigned gen = old / nloc;
        if (old + 1u == (gen + 1u) * nloc) {
            __builtin_amdgcn_fence(__ATOMIC_RELEASE, "agent");
            asm volatile("s_waitcnt vmcnt(0)" ::: "memory");
            const unsigned og = xb_add(&bar[XB_TOP], 1u);
            const unsigned tg = og / nx;
            if (og + 1u == (tg + 1u) * nx) xb_add(&bar[XB_TOPGEN], 1u);
            else XB_SPIN(xb_ld(&bar[XB_TOPGEN]) == tg, bar);
            __builtin_amdgcn_fence(__ATOMIC_ACQUIRE, "agent");
            xb_add(&bar[XB_XGEN(x)], 1u);
            asm volatile("s_waitcnt vmcnt(0)" ::: "memory");
        } else {
            XB_SPIN(xb_ld(&bar[XB_XGEN(x)]) == gen, bar);
            __builtin_amdgcn_fence(__ATOMIC_ACQUIRE, "agent");
            asm volatile("s_waitcnt vmcnt(0)" ::: "memory");
        }
    }
    __syncthreads();
}

__global__ void __launch_bounds__(512, 2) fwd_megakernel(Params p) {
    extern __shared__ __attribute__((aligned(16))) unsigned char shm[];
    LAS unsigned char* lds3 = (LAS unsigned char*)shm;
    const int ph_lo = kp4()->ph_lo, ph_hi = kp4()->ph_hi;
    {
        volatile LAS unsigned* st = (volatile LAS unsigned*)(lds3 + 131072 + 64);
        if (tid_now() == 0) { st[0] = 0u; st[1] = 0u; }
        __syncthreads();
    }
    int rep = 0;
    for (int ph = ph_lo; ph < ph_hi;) {
        unsigned char* ws = kws();
        bool again = false;
        { const int pmk = kp4()->probe; const int kk = ph < 2 ? -1 : (ph - 2) % 10;
            if (rep == 0 && (((pmk & 1) && ph == 0) || ((pmk & 2) && (kk == 3 || kk == 5)) || ((pmk & 4) && kk == 4) || ((pmk & 8) && (kk == 0 || kk == 7)) || ((pmk & 16) && (kk == 1 || kk == 8)) || ((pmk & 32) && ph == 1))) again = true; }
        int G = gridDim.x, c = blockIdx.x; asm volatile("" : "+s"(G), "+s"(c));
        if (ph <= 1) {
            if (ph == 0 && c == 0 && rep == 0) { unsigned* ctl = (unsigned*)(ws + OFF_CTL); for (int i = tid_now(); i < (int)(CTL_BYTES / 4); i += 512) ctl[i] = 0u; }
#ifndef DIS_ROW
            if (ph == 1) row_phase(-1, 0, 0.f, 0, 0);
#endif
#ifndef DIS_PREP
            {
                const int st0 = ph == 0 ? 0 : 5, st1 = ph == 0 ? (G != 256 ? 6 : 1) : (G != 256 ? 5 : 6);
                for (int st = st0; st < st1; ++st) prep_phase((LAS float*)lds3, st, c, G);
            }
#endif
        }
        else {
            const int l = (ph - 2) / 10, k = (ph - 2) % 10;
            if (k == 0 || k == 7) {
                const int s = k == 0 ? 0 : 1;
                pg8::StaticOrder S; S.init(NTOK, 2 * DFF, G, c);
                EpiSwiglu E; E.dummy = 0;
#ifndef DIS_G1
                pg8::gemm_phase(lds3, pg8::Gemm{(const bf16_t*)(ws + OFF_H), (const bf16_t*)(ws + OFF_WGU + (size_t)(l * 2 + s) * SZ_WGU), NTOK, 2 * DFF, 1024}, S, E);
#endif
                if (rep == 0 && c >= 128 && G == 256 && (l == 0 || k == 0)) prep_phase((LAS float*)lds3, l == 1 ? 4 : (k == 0 ? 1 : 2), c - 128, 128);
            } else if (k == 1 || k == 8 || k == 5) {
                pg8::Gemm gm;
                if (k == 5) gm = pg8::Gemm{(const bf16_t*)(ws + OFF_CAT), (const bf16_t*)(ws + OFF_WOUT + (size_t)l * SZ_WOUT), NTOK, 1024, 1280};
                else gm = pg8::Gemm{(const bf16_t*)(ws + OFF_ACT), (const bf16_t*)(ws + OFF_WDN + (size_t)(l * 2 + (k == 1 ? 0 : 1)) * SZ_WDN), NTOK, 1024, DFF};
                pg8::StaticOrder S; S.init(NTOK, 1024, G, c);
                EpiY E; E.ldc = 1024;
#ifndef DIS_GY
                pg8::gemm_phase(lds3, gm, S, E);
#endif
            } else if (k == 2) { row_phase(l, 0, 0.5f, l, 1); cache_convert(l, lds3); }
            else if (k == 3) {
                pg8::StaticOrder S; S.init(NTOK, NIN, G, c);
                EpiIn E; E.layer = l;
#ifndef DIS_GIN
                pg8::gemm_phase(lds3, pg8::Gemm{(const bf16_t*)(ws + OFF_H), (const bf16_t*)(ws + OFF_WIN + (size_t)l * SZ_WIN), NTOK, NIN, 1024}, S, E);
#endif
                if (l == 0 && rep == 0 && c >= 192 && G == 256) prep_phase((LAS float*)lds3, 3, c - 192, 64);
            } else if (k == 4) {
                const int pmx = kp4()->probe;
                if (c < 128 && !(rep == 1 && (pmx & 64))) {
                    const bool lt = c < 64; const int cc = c & 63, part = cc >> 5, uu = cc & 31;
                    pg8::OneUnit S; S.valid = 1; S.pm = lt ? (uu & 7) : 0; S.pn = lt ? (uu >> 3) : uu;
                    EpiDft E; E.tokbase = lt ? NCTX : 0; E.seqlen = lt ? 2048 : 256; E.coloff = 768 + part * 256;
                    pg8::Gemm gm = lt ? pg8::Gemm{(const bf16_t*)(ws + OFF_DLAT) + (size_t)part * 2048 * 2048, (const bf16_t*)(ws + OFF_FTL) + (size_t)part * 1024 * 2048, 2048, 1024, 2048}
                                      : pg8::Gemm{(const bf16_t*)(ws + OFF_DCTX) + (size_t)part * 256 * 256, (const bf16_t*)(ws + OFF_FTC) + (size_t)part * 8192 * 256, 256, 8192, 256};
#ifndef DIS_DFT
                    pg8::gemm_phase(lds3, gm, S, E);
#endif
                }
                volatile LAS int* sitem = (volatile LAS int*)(lds3 + 131072);
                const int myx = (int)(xb_xcc_id() & 7u);
                for (int xo = 0; xo < 8; ++xo) {
                    const int xq = (myx + xo) & 7;
                    unsigned* ctr = (unsigned*)(ws + OFF_CTL) + 4096 + 64 * ((rep * 2 + l) * 8 + xq);
                    for (;;) {
                        __syncthreads();
                        if (tid_now() == 0) *sitem = (int)atomicAdd(ctr, 1u);
                        __syncthreads();
                        const int i = *sitem;
                        if (i >= 64 || (rep == 1 && (pmx & 128))) break;
                        const int item = i < 32 ? 32 * xq + i : 256 + 32 * xq + (i - 32);
#ifndef DIS_ATT
                        attn_item(item, l, lds3);
#endif
                    }
                }
            } else if (k == 6) row_phase(l, 1, 1.0f, l, 2);
            else if (k == 9) row_phase(l, 2, 0.5f, l + 1 < 2 ? l + 1 : -1, 0);
        }
        if (again || ph + 1 < ph_hi) {
            if (ph == 0 && rep == 0) { cg::this_grid().sync();
                if (tid_now() == 0) (void)xb_add(&((unsigned*)(kws() + OFF_CTL))[XB_XCNT(xb_xcc_id())], 1u); }
            else xcd_barrier((unsigned*)(kws() + OFF_CTL), (volatile LAS unsigned*)(lds3 + 131072 + 64));
        }
        if (again) rep = 1; else { rep = 0; ++ph; }
    }
}

extern "C" void kernel_launch(void* const* d_in, const int* in_sizes, int n_in, void* d_out, int out_size, void* d_ws, size_t ws_size, hipStream_t stream) {
    static int grid = 0;
    if (grid == 0) {
        if (ws_size < WS_END) { fprintf(stderr, "kernel_launch: workspace too small: %zu < %zu\n", ws_size, (size_t)WS_END); grid = -1; return; }
        if (hipFuncSetAttribute((const void*)fwd_megakernel, hipFuncAttributeMaxDynamicSharedMemorySize, LDS_BYTES) != hipSuccess) { fprintf(stderr, "kernel_launch: hipFuncSetAttribute failed\n"); grid = -1; return; }
        int dev = 0, cus = 0, per_cu = 0;
        hipGetDevice(&dev); hipDeviceGetAttribute(&cus, hipDeviceAttributeMultiprocessorCount, dev);
        hipOccupancyMaxActiveBlocksPerMultiprocessor(&per_cu, (const void*)fwd_megakernel, 512, LDS_BYTES);
        if (per_cu < 1) { fprintf(stderr, "kernel_launch: occupancy query says %d blocks per CU\n", per_cu); per_cu = 1; }
        (void)hipGetLastError();
        grid = cus;
    }
    if (grid < 0) return;
    Params p{};
    for (int i = 0; i < 16; ++i) p.in[i] = (const float*)d_in[i];
    p.out = (float*)d_out; p.ws = (unsigned char*)d_ws; p.probe = PROBE_MASK;
#if MK_PER_PHASE
    for (int ph = 0; ph < NPHASE; ++ph) { p.ph_lo = ph; p.ph_hi = ph + 1; hipLaunchKernelGGL(fwd_megakernel, dim3(grid), dim3(512), LDS_BYTES, stream, p); }
#else
    p.ph_lo = 0; p.ph_hi = NPHASE;
    void* args[] = {&p};
    hipError_t e = hipLaunchCooperativeKernel((const void*)fwd_megakernel, dim3(grid), dim3(512), args, LDS_BYTES, stream);
    if (e != hipSuccess) fprintf(stderr, "cooperative launch failed: %s (grid %d)\n", hipGetErrorString(e), grid);
#endif
}
```
